# Optimizing an MI355X kernel written in HIP

```python
import math
import jax, jax.numpy as jnp
from jax import lax
import numpy as np

D_MODEL = 1024
BATCH = 4
SEQ = 4096
DEPTH = 2

CTX_LEN = 256
GRID_W = 64

S5_WIDTH = 512
S5_GROUP = 16
S5_GROUPS = S5_WIDTH // S5_GROUP
S5_STATE = 64
S5_DT_MIN = 1e-3
S5_DT_MAX = 1e-1
SC_WIDTH = 512
HY_WIDTH = 512
HY_BANDS = 16
HY_EMB = 1 + 2 * HY_BANDS
HY_FILTER_HIDDEN = 64
HY_FAST_DECAY = 0.3
HY_SLOW_DECAY = 1.5
HY_DECAY_TARGET = 1e-2
HY_DECAY_SHIFT = 0.05
HY_MAX_DECAY = math.log(HY_DECAY_TARGET) / HY_FAST_DECAY
HY_MIN_DECAY = math.log(HY_DECAY_TARGET) / HY_SLOW_DECAY

N_BRANCH = 3
D_FF = 4 * D_MODEL
N_MOD = 6
EPS = 1e-6

OFF_S5 = 0
OFF_SC = OFF_S5 + S5_WIDTH
OFF_HY = OFF_SC + 3 * SC_WIDTH
OFF_GATE = OFF_HY + 3 * HY_WIDTH
D_IN = OFF_GATE + N_BRANCH * D_MODEL

kernel_name = "hybrid_s5_shortconv_hyena_prefix_dit"

F32 = jnp.float32


def rmsnorm(x, g):
    xf = x.astype(F32)
    y = xf * lax.rsqrt(jnp.mean(xf * xf, axis=-1, keepdims=True) + EPS)
    return (y * g.astype(F32)).astype(x.dtype)


def modulate(h, shift, scale):
    return h * (1.0 + scale) + shift


def sincos_2d(rows, cols, dim):
    quarter = dim // 4
    omega = 1.0 / (10000.0 ** (jnp.arange(quarter, dtype=F32) / quarter))
    er = jnp.arange(rows, dtype=F32)[:, None] * omega[None]
    ec = jnp.arange(cols, dtype=F32)[:, None] * omega[None]
    er = jnp.concatenate([jnp.sin(er), jnp.cos(er)], axis=-1)
    ec = jnp.concatenate([jnp.sin(ec), jnp.cos(ec)], axis=-1)
    emb = jnp.concatenate([
        jnp.broadcast_to(er[:, None, :], (rows, cols, dim // 2)),
        jnp.broadcast_to(ec[None, :, :], (rows, cols, dim // 2))], axis=-1)
    return emb.reshape(rows * cols, dim)


def conv3(x, w, b=None):
    xp = jnp.pad(x, ((0, 0), (1, 1), (0, 0)))
    y = w[0] * xp[:, :-2] + w[1] * xp[:, 1:-1] + w[2] * xp[:, 2:]
    if b is not None:
        y = y + b
    return y


def s5_discretise(a_re, a_im, log_dt, b_re, b_im):
    a_re = a_re.astype(F32); a_im = a_im.astype(F32)
    dt = jnp.exp(log_dt.astype(F32))[:, None]
    mag = jnp.exp(a_re * dt)
    ang = a_im * dt
    abar_re = mag * jnp.cos(ang)
    abar_im = mag * jnp.sin(ang)
    den = a_re * a_re + a_im * a_im
    nr = abar_re - 1.0
    ni = abar_im
    f_re = (nr * a_re + ni * a_im) / den
    f_im = (ni * a_re - nr * a_im) / den
    b_re = b_re.astype(F32); b_im = b_im.astype(F32)
    bb_re = f_re[..., None] * b_re - f_im[..., None] * b_im
    bb_im = f_re[..., None] * b_im + f_im[..., None] * b_re
    return abar_re, abar_im, bb_re, bb_im


def _cscan_combine(e1, e2):
    a1r, a1i, b1r, b1i = e1
    a2r, a2i, b2r, b2i = e2
    return (a2r * a1r - a2i * a1i,
            a2r * a1i + a2i * a1r,
            a2r * b1r - a2i * b1i + b2r,
            a2r * b1i + a2i * b1r + b2i)


def s5_mixer(u, lp, init, readout):
    bsz, L, _ = u.shape
    uf = u.astype(F32)
    ug = uf.reshape(bsz, L, S5_GROUPS, S5_GROUP)
    states = []
    finals = []
    for k, rev in enumerate((False, True)):
        abr, abi, bbr, bbi = s5_discretise(lp["s5_a_re"][k], lp["s5_a_im"][k], lp["s5_log_dt"][k],
                                           lp["s5_b_re"][k], lp["s5_b_im"][k])
        bur = jnp.einsum("blgp,gnp->blgn", ug, bbr)
        bui = jnp.einsum("blgp,gnp->blgn", ug, bbi)
        if init is not None:
            s0r, s0i = init[k]
            edge = -1 if rev else 0
            bur = bur.at[:, edge].add(abr * s0r - abi * s0i)
            bui = bui.at[:, edge].add(abr * s0i + abi * s0r)
        ar = jnp.broadcast_to(abr, bur.shape)
        ai = jnp.broadcast_to(abi, bui.shape)
        _, _, sr, si = lax.associative_scan(_cscan_combine, (ar, ai, bur, bui), reverse=rev, axis=1)
        last = 0 if rev else -1
        finals.append((sr[:, last], si[:, last]))
        states.append((k, sr, si))
    if not readout:
        return None, finals
    y = uf * lp["s5_d"].astype(F32)
    for k, sr, si in states:
        cr = lp["s5_c_re"][k].astype(F32)
        ci = lp["s5_c_im"][k].astype(F32)
        yk = jnp.einsum("blgn,gpn->blgp", sr, cr) - jnp.einsum("blgn,gpn->blgp", si, ci)
        y = y + yk.reshape(bsz, L, S5_WIDTH)
    h = jax.nn.gelu(y).astype(u.dtype)
    a, g = jnp.split(h @ lp["s5_glu_w"], 2, axis=-1)
    return a * jax.nn.sigmoid(g), finals


def short_conv_branch(p, lp):
    sc_x, sc_b, sc_c = jnp.split(p[..., OFF_SC:OFF_HY], 3, axis=-1)
    return (sc_b * conv3(sc_c * sc_x, lp["sc_conv_w"])) @ lp["sc_out_w"]


def hyena_filter(L, lp):
    t = jnp.linspace(0.0, 1.0, L, dtype=F32)[:, None]
    ang = 2.0 * math.pi * jnp.arange(L, dtype=F32)[:, None] / L
    bands = jnp.linspace(1e-4, HY_BANDS - 1, HY_BANDS, dtype=F32)[None, :]
    z = jnp.concatenate([t, jnp.cos(bands * ang), -jnp.sin(bands * ang)], axis=-1)
    freq = lp["hy_f_freq"].astype(F32)
    h = jnp.sin(freq * (z @ lp["hy_f_w1"].astype(F32) + lp["hy_f_b1"].astype(F32)))
    h = jnp.sin(freq * (h @ lp["hy_f_w2"].astype(F32) + lp["hy_f_b2"].astype(F32)))
    h = jnp.sin(freq * (h @ lp["hy_f_w3"].astype(F32) + lp["hy_f_b3"].astype(F32)))
    h = h @ lp["hy_f_w4"].astype(F32)
    deltas = jnp.abs(jnp.linspace(HY_MIN_DECAY, HY_MAX_DECAY, HY_WIDTH, dtype=F32))
    window = jnp.exp(-t * deltas[None, :]) + HY_DECAY_SHIFT
    h_f = h[:, :HY_WIDTH] * window
    h_b = h[:, HY_WIDTH:] * window
    k = jnp.concatenate([h_f, jnp.zeros((1, HY_WIDTH), F32), h_b[:0:-1]], axis=0)
    return k / jnp.sum(jnp.abs(k), axis=0, keepdims=True)


def fft_long_conv(u, k, d):
    L = u.shape[1]
    uf = u.astype(F32)
    U = jnp.fft.rfft(uf, n=2 * L, axis=1)
    K = jnp.fft.rfft(k, n=2 * L, axis=0)
    y = jnp.fft.irfft(U * K[None], n=2 * L, axis=1)[:, :L]
    return y + uf * d.astype(F32)


def hyena_branch(p, lp):
    L = p.shape[1]
    q = conv3(p[..., OFF_HY:OFF_GATE], lp["hy_conv_w"], lp["hy_conv_b"])
    v, x1, x0 = jnp.split(q, 3, axis=-1)
    z = fft_long_conv(x1 * v, hyena_filter(L, lp), lp["hy_d"]).astype(p.dtype)
    return (x0 * z) @ lp["hy_out_w"]


def merge_branches(p, y_s5, lp):
    g = jax.nn.sigmoid(p[..., OFF_GATE:]).reshape(p.shape[:-1] + (N_BRANCH, D_MODEL))
    m = (g[..., 0, :] * y_s5
         + g[..., 1, :] * short_conv_branch(p, lp)
         + g[..., 2, :] * hyena_branch(p, lp))
    return m @ lp["out_w"]


def channel_mixer(h, lp):
    r = jax.nn.relu(h @ lp["mlp_w1"])
    return (r * r) @ lp["mlp_w2"]


def setup_inputs(seed: int = 0) -> dict:
    key = jax.random.key(seed)
    ks = iter(jax.random.split(key, 48))

    def nrm(shape, scale):
        return jax.random.normal(next(ks), shape, F32) * scale

    G, N, P, H = S5_GROUPS, S5_STATE, S5_GROUP, HY_FILTER_HIDDEN
    inp = {}
    inp["x"] = nrm((BATCH, SEQ, D_MODEL), 1.0)
    inp["c"] = nrm((BATCH, D_MODEL), 1.0)
    inp["ctx"] = nrm((BATCH, CTX_LEN, D_MODEL), 1.0)
    inp["c_ctx"] = nrm((D_MODEL,), 1.0)
    inp["ada_w"] = nrm((DEPTH, D_MODEL, N_MOD * D_MODEL), 0.5 * D_MODEL ** -0.5)
    inp["ada_b"] = nrm((DEPTH, N_MOD * D_MODEL), 0.02)
    inp["norm1_g"] = 1.0 + nrm((DEPTH, D_MODEL), 0.05)
    inp["norm2_g"] = 1.0 + nrm((DEPTH, D_MODEL), 0.05)
    inp["w_in"] = nrm((DEPTH, D_MODEL, D_IN), D_MODEL ** -0.5)
    inp["s5_a_re"] = -0.5 + nrm((DEPTH, 2, G, N), 0.01)
    inp["s5_a_im"] = math.pi * jnp.arange(N, dtype=F32) + nrm((DEPTH, 2, G, N), 0.01)
    inp["s5_log_dt"] = jax.random.uniform(next(ks), (DEPTH, 2, G), F32,
                                          math.log(S5_DT_MIN), math.log(S5_DT_MAX))
    inp["s5_b_re"] = nrm((DEPTH, 2, G, N, P), (2 * P) ** -0.5)
    inp["s5_b_im"] = nrm((DEPTH, 2, G, N, P), (2 * P) ** -0.5)
    inp["s5_c_re"] = nrm((DEPTH, 2, G, P, N), (2 * N) ** -0.5)
    inp["s5_c_im"] = nrm((DEPTH, 2, G, P, N), (2 * N) ** -0.5)
    inp["s5_d"] = nrm((DEPTH, S5_WIDTH), 1.0)
    inp["s5_glu_w"] = nrm((DEPTH, S5_WIDTH, 2 * D_MODEL), S5_WIDTH ** -0.5)
    inp["sc_conv_w"] = nrm((DEPTH, 3, SC_WIDTH), 3 ** -0.5)
    inp["sc_out_w"] = nrm((DEPTH, SC_WIDTH, D_MODEL), SC_WIDTH ** -0.5)
    inp["hy_conv_w"] = nrm((DEPTH, 3, 3 * HY_WIDTH), 3 ** -0.5)
    inp["hy_conv_b"] = nrm((DEPTH, 3 * HY_WIDTH), 0.02)
    inp["hy_f_w1"] = nrm((DEPTH, HY_EMB, H), HY_EMB ** -0.5)
    inp["hy_f_b1"] = nrm((DEPTH, H), 0.1)
    inp["hy_f_w2"] = nrm((DEPTH, H, H), H ** -0.5)
    inp["hy_f_b2"] = nrm((DEPTH, H), 0.1)
    inp["hy_f_w3"] = nrm((DEPTH, H, H), H ** -0.5)
    inp["hy_f_b3"] = nrm((DEPTH, H), 0.1)
    inp["hy_f_freq"] = 1.0 + nrm((DEPTH, H), 0.05)
    inp["hy_f_w4"] = nrm((DEPTH, H, 2 * HY_WIDTH), H ** -0.5)
    inp["hy_d"] = nrm((DEPTH, HY_WIDTH), 0.1)
    inp["hy_out_w"] = nrm((DEPTH, HY_WIDTH, D_MODEL), HY_WIDTH ** -0.5)
    inp["out_w"] = nrm((DEPTH, D_MODEL, D_MODEL), D_MODEL ** -0.5)
    inp["mlp_w1"] = nrm((DEPTH, D_MODEL, D_FF), D_MODEL ** -0.5)
    inp["mlp_w2"] = nrm((DEPTH, D_FF, D_MODEL), D_FF ** -0.5)
    inp["final_g"] = 1.0 + nrm((D_MODEL,), 0.05)
    return inp


def reference(x, c, ctx, c_ctx, ada_w, ada_b, norm1_g, norm2_g, w_in,
              s5_a_re, s5_a_im, s5_log_dt, s5_b_re, s5_b_im, s5_c_re, s5_c_im, s5_d, s5_glu_w,
              sc_conv_w, sc_out_w, hy_conv_w, hy_conv_b,
              hy_f_w1, hy_f_b1, hy_f_w2, hy_f_b2, hy_f_w3, hy_f_b3, hy_f_freq, hy_f_w4,
              hy_d, hy_out_w, out_w, mlp_w1, mlp_w2, final_g):
    L = x.shape[1]
    rows = L // GRID_W
    x = x + sincos_2d(rows, GRID_W, D_MODEL).astype(x.dtype)[None]
    xc = ctx
    sc_vec = jax.nn.silu(c)
    sc_ctx_vec = jax.nn.silu(c_ctx)
    for l in range(DEPTH):
        last = l == DEPTH - 1
        lp = {
            "s5_a_re": s5_a_re[l], "s5_a_im": s5_a_im[l], "s5_log_dt": s5_log_dt[l],
            "s5_b_re": s5_b_re[l], "s5_b_im": s5_b_im[l], "s5_c_re": s5_c_re[l],
            "s5_c_im": s5_c_im[l], "s5_d": s5_d[l], "s5_glu_w": s5_glu_w[l],
            "sc_conv_w": sc_conv_w[l], "sc_out_w": sc_out_w[l],
            "hy_conv_w": hy_conv_w[l], "hy_conv_b": hy_conv_b[l],
            "hy_f_w1": hy_f_w1[l], "hy_f_b1": hy_f_b1[l], "hy_f_w2": hy_f_w2[l],
            "hy_f_b2": hy_f_b2[l], "hy_f_w3": hy_f_w3[l], "hy_f_b3": hy_f_b3[l],
            "hy_f_freq": hy_f_freq[l], "hy_f_w4": hy_f_w4[l], "hy_d": hy_d[l],
            "hy_out_w": hy_out_w[l], "out_w": out_w[l],
            "mlp_w1": mlp_w1[l], "mlp_w2": mlp_w2[l],
        }
        mod = (sc_vec @ ada_w[l] + ada_b[l])[:, None, :]
        mod_c = sc_ctx_vec @ ada_w[l] + ada_b[l]
        sh1, scl1, g1, sh2, scl2, g2 = jnp.split(mod, N_MOD, axis=-1)
        csh1, cscl1, cg1, csh2, cscl2, cg2 = jnp.split(mod_c, N_MOD, axis=-1)
        w_in_l = w_in[l]

        hc = modulate(rmsnorm(xc, norm1_g[l]), csh1, cscl1)
        pc = hc @ (w_in_l[:, OFF_S5:OFF_S5 + S5_WIDTH] if last else w_in_l)
        yc_s5, ctx_final = s5_mixer(pc[..., OFF_S5:OFF_S5 + S5_WIDTH], lp, None, not last)

        h = modulate(rmsnorm(x, norm1_g[l]), sh1, scl1)
        p = h @ w_in_l
        y_s5, _ = s5_mixer(p[..., OFF_S5:OFF_S5 + S5_WIDTH], lp, ctx_final, True)
        x = x + g1 * merge_branches(p, y_s5, lp)
        x = x + g2 * channel_mixer(modulate(rmsnorm(x, norm2_g[l]), sh2, scl2), lp)

        if not last:
            xc = xc + cg1 * merge_branches(pc, yc_s5, lp)
            xc = xc + cg2 * channel_mixer(modulate(rmsnorm(xc, norm2_g[l]), csh2, cscl2), lp)
    return rmsnorm(x, final_g)
```

```cpp
#include <hip/hip_runtime.h>
#include <math.h>
#include <stdio.h>

namespace nv {
constexpr int D = 1024, NB = 4, SEQ = 4096, CTX = 256, DIN = 6656, DFF = 4096, NMOD = 6 * 1024;
constexpr int OFF_SC = 512, OFF_HY = 2048, OFF_GATE = 3584;

__device__ __forceinline__ float sigmoidf_(float x) { return 1.f / (1.f + expf(-x)); }

__global__ void k_mod(const float* c, const float* c_ctx, const float* ada_w, const float* ada_b, float* mod) {
    const int n = blockIdx.x * 256 + threadIdx.x, r = blockIdx.y, l = blockIdx.z;
    const float* v = r < 4 ? c + r * 1024 : c_ctx;
    __shared__ float sv[1024];
    for (int k = threadIdx.x; k < 1024; k += 256) { const float x = v[k]; sv[k] = x / (1.f + expf(-x)); }
    __syncthreads();
    const float* W = ada_w + (size_t)l * 1024 * NMOD;
    float acc = 0.f;
    for (int k = 0; k < 1024; ++k) acc += sv[k] * W[(size_t)k * NMOD + n];
    mod[((size_t)l * 5 + r) * NMOD + n] = acc + ada_b[l * NMOD + n];
}

__global__ void k_posadd(const float* x, float* out) {
    const int row = blockIdx.x, t = row % SEQ, r = t / 64, cc = t % 64;
    for (int d = threadIdx.x; d < 1024; d += 256) {
        const int half = d >> 9, dd = d & 511, isc = dd >> 8, i = dd & 255;
        const float omega = 1.0f / powf(10000.0f, (float)i / 256.0f);
        const float a = (half ? (float)cc : (float)r) * omega;
        out[(size_t)row * 1024 + d] = x[(size_t)row * 1024 + d] + (isc ? cosf(a) : sinf(a));
    }
}

__global__ void k_norm_mod(const float* x, const float* g, const float* shift, const float* scale, float* out) {
    const int row = blockIdx.x;
    const float* xr = x + (size_t)row * 1024;
    float v[4]; float s = 0.f;
    for (int i = 0; i < 4; ++i) { v[i] = xr[threadIdx.x + 256 * i]; s += v[i] * v[i]; }
    __shared__ float red[256];
    red[threadIdx.x] = s; __syncthreads();
    for (int o = 128; o > 0; o >>= 1) { if (threadIdx.x < o) red[threadIdx.x] += red[threadIdx.x + o]; __syncthreads(); }
    const float rs = rsqrtf(red[0] * (1.f / 1024.f) + 1e-6f);
    for (int i = 0; i < 4; ++i) { const int d = threadIdx.x + 256 * i; float y = v[i] * rs * g[d]; if (shift) y = y * (1.f + scale[d]) + shift[d]; out[(size_t)row * 1024 + d] = y; }
}

__global__ __launch_bounds__(256) void k_gemm(const float* A, int lda, const float* W, int ldw, float* C, int ldc, int K) {
    __shared__ float As[16][132];
    __shared__ float Bs[16][132];
    const int tid = threadIdx.x, tx = tid & 15, ty = tid >> 4;
    const int m0 = blockIdx.y * 128, n0 = blockIdx.x * 128;
    float acc[8][8];
#pragma unroll
    for (int i = 0; i < 8; ++i)
#pragma unroll
        for (int j = 0; j < 8; ++j) acc[i][j] = 0.f;
    for (int k0 = 0; k0 < K; k0 += 16) {
#pragma unroll
        for (int i = 0; i < 2; ++i) {
            const int idx = tid + 256 * i, row = idx >> 2, kq = (idx & 3) * 4;
            const float4 a = *(const float4*)(A + (size_t)(m0 + row) * lda + k0 + kq);
            As[kq + 0][row] = a.x; As[kq + 1][row] = a.y; As[kq + 2][row] = a.z; As[kq + 3][row] = a.w;
            const int kr = idx >> 5, nq = (idx & 31) * 4;
            const float4 b = *(const float4*)(W + (size_t)(k0 + kr) * ldw + n0 + nq);
            *(float4*)&Bs[kr][nq] = b;
        }
        __syncthreads();
#pragma unroll
        for (int kk = 0; kk < 16; ++kk) {
            const float4 a0 = *(const float4*)&As[kk][ty * 8], a1 = *(const float4*)&As[kk][ty * 8 + 4];
            const float4 b0 = *(const float4*)&Bs[kk][tx * 8], b1 = *(const float4*)&Bs[kk][tx * 8 + 4];
            const float a[8] = {a0.x, a0.y, a0.z, a0.w, a1.x, a1.y, a1.z, a1.w};
            const float b[8] = {b0.x, b0.y, b0.z, b0.w, b1.x, b1.y, b1.z, b1.w};
#pragma unroll
            for (int i = 0; i < 8; ++i)
#pragma unroll
                for (int j = 0; j < 8; ++j) acc[i][j] += a[i] * b[j];
        }
        __syncthreads();
    }
#pragma unroll
    for (int i = 0; i < 8; ++i) {
        float* cr = C + (size_t)(m0 + ty * 8 + i) * ldc + n0 + tx * 8;
        *(float4*)cr = make_float4(acc[i][0], acc[i][1], acc[i][2], acc[i][3]);
        *(float4*)(cr + 4) = make_float4(acc[i][4], acc[i][5], acc[i][6], acc[i][7]);
    }
}

__global__ __launch_bounds__(64) void k_s5(const float* p, int ldp, int L, const float* a_re, const float* a_im, const float* log_dt,
                                           const float* b_re, const float* b_im, const float* c_re, const float* c_im,
                                           const float* init, float* finals, float* ydir) {
    const int g = blockIdx.x, k = blockIdx.y, n = threadIdx.x;
    __shared__ float s_re[64][65], s_im[64][65];
    __shared__ float cr[16][64], ci[16][64];
    __shared__ float us[64][16];
    const int kg = k * 32 + g;
    const float are = a_re[kg * 64 + n], aim = a_im[kg * 64 + n], dt = expf(log_dt[kg]);
    const float mag = expf(are * dt), ang = aim * dt, abr = mag * cosf(ang), abi = mag * sinf(ang);
    const float den = are * are + aim * aim, nr = abr - 1.f, ni = abi;
    const float fre = (nr * are + ni * aim) / den, fim = (ni * are - nr * aim) / den;
    float bbr[16], bbi[16];
#pragma unroll
    for (int q = 0; q < 16; ++q) {
        const float br = b_re[((size_t)kg * 64 + n) * 16 + q], bi = b_im[((size_t)kg * 64 + n) * 16 + q];
        bbr[q] = fre * br - fim * bi; bbi[q] = fre * bi + fim * br;
    }
    for (int q = 0; q < 16; ++q) { cr[q][n] = c_re[((size_t)kg * 16 + q) * 64 + n]; ci[q][n] = c_im[((size_t)kg * 16 + q) * 64 + n]; }
    float sr = 0.f, si = 0.f;
    if (init) { sr = init[(kg * 64 + n) * 2 + 0]; si = init[(kg * 64 + n) * 2 + 1]; }
    const int nch = L / 64;
#pragma unroll 1
    for (int ch = 0; ch < nch; ++ch) {
        const int c = k ? nch - 1 - ch : ch, t0 = c * 64;
        __syncthreads();
        for (int i = 0; i < 16; ++i) { const int e = n + 64 * i, j = e >> 4, q = e & 15; us[j][q] = p[(size_t)(t0 + j) * ldp + g * 16 + q]; }
        __syncthreads();
#pragma unroll 1
        for (int jj = 0; jj < 64; ++jj) {
            const int j = k ? 63 - jj : jj;
            float bur = 0.f, bui = 0.f;
#pragma unroll
            for (int q = 0; q < 16; ++q) { const float u = us[j][q]; bur += u * bbr[q]; bui += u * bbi[q]; }
            const float nsr = abr * sr - abi * si + bur, nsi = abr * si + abi * sr + bui;
            sr = nsr; si = nsi;
            s_re[j][n] = sr; s_im[j][n] = si;
        }
        __syncthreads();
        {
            const int j = n;
#pragma unroll 1
            for (int q = 0; q < 16; ++q) {
                float y = 0.f;
#pragma unroll 8
                for (int m = 0; m < 64; ++m) y += cr[q][m] * s_re[j][m] - ci[q][m] * s_im[j][m];
                ydir[((size_t)k * L + t0 + j) * 512 + g * 16 + q] = y;
            }
        }
    }
    finals[(kg * 64 + n) * 2 + 0] = sr; finals[(kg * 64 + n) * 2 + 1] = si;
}

__device__ __forceinline__ float gelu_tanh(float x) { return 0.5f * x * (1.f + tanhf(0.7978845608028654f * (x + 0.044715f * x * x * x))); }

__global__ void k_s5_post(const float* p, int ldp, const float* d, const float* ydir, int L, float* h) {
    const size_t i = (size_t)blockIdx.x * 256 + threadIdx.x; const int t = (int)(i >> 9), c = (int)(i & 511);
    const float y = p[(size_t)t * ldp + c] * d[c] + ydir[i] + ydir[(size_t)L * 512 + i];
    h[i] = gelu_tanh(y);
}
__global__ void k_glu(const float* glu, float* ys5) {
    const size_t i = (size_t)blockIdx.x * 256 + threadIdx.x; const size_t t = i >> 10; const int c = (int)(i & 1023);
    ys5[i] = glu[t * 2048 + c] * sigmoidf_(glu[t * 2048 + 1024 + c]);
}
__global__ void k_sc_pre(const float* p, int ldp, int L, const float* w, float* scA) {
    const size_t i = (size_t)blockIdx.x * 256 + threadIdx.x; const int t = (int)(i >> 9), c = (int)(i & 511);
    const float* pr = p + (size_t)t * ldp + OFF_SC;
    auto cx = [&](int tt) -> float { if (tt < 0 || tt >= L) return 0.f; const float* q = p + (size_t)tt * ldp + OFF_SC; return q[1024 + c] * q[c]; };
    const float y = w[c] * cx(t - 1) + w[512 + c] * cx(t) + w[1024 + c] * cx(t + 1);
    scA[i] = pr[512 + c] * y;
}
__global__ void k_hy_pre(const float* p, int ldp, int L, const float* w, const float* b, float* q) {
    const size_t i = (size_t)blockIdx.x * 256 + threadIdx.x; const int t = (int)(i / 1536), j = (int)(i % 1536);
    auto px = [&](int tt) -> float { if (tt < 0 || tt >= L) return 0.f; return p[(size_t)tt * ldp + OFF_HY + j]; };
    q[i] = w[j] * px(t - 1) + w[1536 + j] * px(t) + w[3072 + j] * px(t + 1) + b[j];
}
__global__ void k_hy_u(const float* q, float* u) {
    const size_t i = (size_t)blockIdx.x * 256 + threadIdx.x; const size_t t = i >> 9; const int c = (int)(i & 511);
    u[i] = q[t * 1536 + 512 + c] * q[t * 1536 + c];
}
__global__ __launch_bounds__(64) void k_filt_mlp(int L, const float* w1, const float* b1, const float* w2, const float* b2, const float* w3, const float* b3, const float* freq, float* H3) {
    const int t = blockIdx.x, j = threadIdx.x;
    __shared__ float z[33], h[64], h2[64];
    if (j == 0) z[0] = (float)t / (float)(L - 1);
    if (j < 16) {
        const float band = 1e-4f + (float)j * ((15.0f - 1e-4f) / 15.0f);
        const float ang = 6.283185307179586f * (float)t / (float)L;
        z[1 + j] = cosf(band * ang); z[17 + j] = -sinf(band * ang);
    }
    __syncthreads();
    const float f = freq[j];
    float a = b1[j];
    for (int i = 0; i < 33; ++i) a += z[i] * w1[i * 64 + j];
    h[j] = sinf(f * a); __syncthreads();
    a = b2[j];
    for (int i = 0; i < 64; ++i) a += h[i] * w2[i * 64 + j];
    h2[j] = sinf(f * a); __syncthreads();
    a = b3[j];
    for (int i = 0; i < 64; ++i) a += h2[i] * w3[i * 64 + j];
    H3[t * 64 + j] = sinf(f * a);
}
__global__ void k_filt_out(int L, const float* H3, const float* w4, float* kbuf) {
    const size_t i = (size_t)blockIdx.x * 256 + threadIdx.x; const int t = (int)(i >> 10), j = (int)(i & 1023);
    float a = 0.f;
    for (int m = 0; m < 64; ++m) a += H3[t * 64 + m] * w4[m * 1024 + j];
    const int c = j & 511;
    const float MIND = -3.0701134573253944f, MAXD = -15.350567286626972f;
    const float delta = fabsf(MIND + (float)c * ((MAXD - MIND) / 511.0f));
    const float tt = (float)t / (float)(L - 1);
    const float v = a * (expf(-tt * delta) + 0.05f);
    if (j < 512) kbuf[(size_t)t * 512 + c] = v;
    else if (t >= 1) kbuf[(size_t)(2 * L - t) * 512 + c] = v;
    if (t == 0 && j < 512) kbuf[(size_t)L * 512 + c] = 0.f;
}
__global__ void k_filt_norm(int L, float* kbuf) {
    const int c = blockIdx.x; float s = 0.f;
    for (int i = threadIdx.x; i < 2 * L; i += 256) s += fabsf(kbuf[(size_t)i * 512 + c]);
    __shared__ float red[256];
    red[threadIdx.x] = s; __syncthreads();
    for (int o = 128; o > 0; o >>= 1) { if (threadIdx.x < o) red[threadIdx.x] += red[threadIdx.x + o]; __syncthreads(); }
    const float inv = 1.f / red[0];
    for (int i = threadIdx.x; i < 2 * L; i += 256) kbuf[(size_t)i * 512 + c] *= inv;
}
__global__ __launch_bounds__(256) void k_hy_conv(const float* u, const float* kbuf, const float* dvec, const float* q, int L, float* hyA) {
    __shared__ float us[64][64];
    __shared__ float ks[128][64];
    const int tid = threadIdx.x, c = tid & 63, tq = tid >> 6, c0 = blockIdx.y * 64, t0 = blockIdx.x * 64;
    float acc[16];
#pragma unroll
    for (int i = 0; i < 16; ++i) acc[i] = 0.f;
    const int twoL = 2 * L;
    for (int s0 = 0; s0 < L; s0 += 64) {
        __syncthreads();
        for (int i = tq; i < 64; i += 4) us[i][c] = u[(size_t)(s0 + i) * 512 + c0 + c];
        for (int i = tq; i < 127; i += 4) { int lag = t0 - s0 + i - 63; lag = ((lag % twoL) + twoL) % twoL; ks[i][c] = kbuf[(size_t)lag * 512 + c0 + c]; }
        __syncthreads();
        for (int sl = 0; sl < 64; ++sl) {
            const float uv = us[sl][c];
#pragma unroll
            for (int i = 0; i < 16; ++i) acc[i] += ks[tq * 16 + i - sl + 63][c] * uv;
        }
    }
#pragma unroll
    for (int i = 0; i < 16; ++i) {
        const int t = t0 + tq * 16 + i; const size_t o = (size_t)t * 512 + c0 + c;
        const float z = acc[i] + u[o] * dvec[c0 + c];
        hyA[o] = q[(size_t)t * 1536 + 1024 + c0 + c] * z;
    }
}
__global__ void k_merge(const float* p, int ldp, const float* ys5, const float* sc, const float* hy, float* m) {
    const size_t i = (size_t)blockIdx.x * 256 + threadIdx.x; const size_t t = i >> 10; const int c = (int)(i & 1023);
    const float* pg = p + t * ldp + OFF_GATE;
    m[i] = sigmoidf_(pg[c]) * ys5[i] + sigmoidf_(pg[1024 + c]) * sc[i] + sigmoidf_(pg[2048 + c]) * hy[i];
}
__global__ void k_resid(float* x, const float* gate, const float* y) {
    const size_t i = (size_t)blockIdx.x * 256 + threadIdx.x; const int c = (int)(i & 1023);
    x[i] += gate[c] * y[i];
}
__global__ void k_relu2(float* r) {
    const size_t i = (size_t)blockIdx.x * 256 + threadIdx.x; const float v = fmaxf(r[i], 0.f); r[i] = v * v;
}
}

extern "C" void kernel_launch(void* const* d_in, const int* in_sizes, int n_in, void* d_out, int out_size, void* d_ws, size_t ws_size, hipStream_t stream) {
    using namespace nv;
    const float* x = (const float*)d_in[0]; const float* cvec = (const float*)d_in[1]; const float* ctx = (const float*)d_in[2]; const float* c_ctx = (const float*)d_in[3];
    const float* ada_w = (const float*)d_in[4]; const float* ada_b = (const float*)d_in[5]; const float* norm1_g = (const float*)d_in[6]; const float* norm2_g = (const float*)d_in[7];
    const float* w_in = (const float*)d_in[8];
    const float* s5_a_re = (const float*)d_in[9]; const float* s5_a_im = (const float*)d_in[10]; const float* s5_log_dt = (const float*)d_in[11];
    const float* s5_b_re = (const float*)d_in[12]; const float* s5_b_im = (const float*)d_in[13]; const float* s5_c_re = (const float*)d_in[14]; const float* s5_c_im = (const float*)d_in[15];
    const float* s5_d = (const float*)d_in[16]; const float* s5_glu_w = (const float*)d_in[17]; const float* sc_conv_w = (const float*)d_in[18]; const float* sc_out_w = (const float*)d_in[19];
    const float* hy_conv_w = (const float*)d_in[20]; const float* hy_conv_b = (const float*)d_in[21];
    const float* hy_f_w1 = (const float*)d_in[22]; const float* hy_f_b1 = (const float*)d_in[23]; const float* hy_f_w2 = (const float*)d_in[24]; const float* hy_f_b2 = (const float*)d_in[25];
    const float* hy_f_w3 = (const float*)d_in[26]; const float* hy_f_b3 = (const float*)d_in[27]; const float* hy_f_freq = (const float*)d_in[28]; const float* hy_f_w4 = (const float*)d_in[29];
    const float* hy_d = (const float*)d_in[30]; const float* hy_out_w = (const float*)d_in[31]; const float* out_w = (const float*)d_in[32];
    const float* mlp_w1 = (const float*)d_in[33]; const float* mlp_w2 = (const float*)d_in[34]; const float* final_g = (const float*)d_in[35];
    float* xs = (float*)d_out;
    float* ws = (float*)d_ws; size_t off = 0;
    auto take = [&](size_t n) { float* p = ws + off; off += (n + 63) & ~(size_t)63; return p; };
    float* mod = take(2 * 5 * NMOD);
    float* xc = take((size_t)NB * CTX * D);
    float* h = take((size_t)SEQ * D);
    float* p = take((size_t)SEQ * DIN);
    float* ydir = take((size_t)2 * SEQ * 512);
    float* m = take((size_t)SEQ * D);
    float* tmp = take((size_t)SEQ * D);
    float* ys5 = take((size_t)SEQ * D);
    float* scO = take((size_t)SEQ * D);
    float* hyO = take((size_t)SEQ * D);
    float* kL = take((size_t)2 * SEQ * 512);
    float* kC = take((size_t)2 * CTX * 512);
    float* H3 = take((size_t)SEQ * 64);
    float* fin = take((size_t)NB * 2 * 32 * 64 * 2);
    float* fin2 = take((size_t)2 * 32 * 64 * 2);
    float* hs5 = h;
    float* glu = m;
    float* scA = h;
    float* q = m;
    float* u = ydir;
    float* hyA = ydir + (size_t)SEQ * 512;
    if (off * 4 > ws_size) { fprintf(stderr, "ws too small: need %zu have %zu\n", off * 4, ws_size); return; }

    k_mod<<<dim3(NMOD / 256, 5, 2), 256, 0, stream>>>(cvec, c_ctx, ada_w, ada_b, mod);
    k_posadd<<<NB * SEQ, 256, 0, stream>>>(x, xs);
    (void)hipMemcpyAsync(xc, ctx, (size_t)NB * CTX * D * 4, hipMemcpyDeviceToDevice, stream);

    auto gemm = [&](const float* A, int lda, const float* W, int ldw, float* C, int ldc, int M, int N, int K) {
        k_gemm<<<dim3(N / 128, M / 128), 256, 0, stream>>>(A, lda, W, ldw, C, ldc, K);
    };
    for (int l = 0; l < 2; ++l) {
        const bool last = (l == 1);
        const float* w_in_l = w_in + (size_t)l * D * DIN;
        for (int which = 0; which < (last ? 1 : 2); ++which) {
            const int L = which ? CTX : SEQ; float* kb = which ? kC : kL;
            k_filt_mlp<<<L, 64, 0, stream>>>(L, hy_f_w1 + l * 33 * 64, hy_f_b1 + l * 64, hy_f_w2 + l * 4096, hy_f_b2 + l * 64, hy_f_w3 + l * 4096, hy_f_b3 + l * 64, hy_f_freq + l * 64, H3);
            k_filt_out<<<L * 1024 / 256, 256, 0, stream>>>(L, H3, hy_f_w4 + (size_t)l * 64 * 1024, kb);
            k_filt_norm<<<512, 256, 0, stream>>>(L, kb);
        }
        auto block = [&](float* xb, int L, const float* modv, const float* init, float* finals, bool full, const float* kb) {
            k_norm_mod<<<L, 256, 0, stream>>>(xb, norm1_g + l * D, modv, modv + 1024, h);
            gemm(h, D, w_in_l, DIN, p, DIN, L, full ? DIN : 512, D);
            k_s5<<<dim3(32, 2), 64, 0, stream>>>(p, DIN, L, s5_a_re + l * 4096, s5_a_im + l * 4096, s5_log_dt + l * 64, s5_b_re + (size_t)l * 65536, s5_b_im + (size_t)l * 65536,
                                                  s5_c_re + (size_t)l * 65536, s5_c_im + (size_t)l * 65536, init, finals, ydir);
            if (!full) return;
            k_s5_post<<<L * 512 / 256, 256, 0, stream>>>(p, DIN, s5_d + l * 512, ydir, L, hs5);
            gemm(hs5, 512, s5_glu_w + (size_t)l * 512 * 2048, 2048, glu, 2048, L, 2048, 512);
            k_glu<<<L * 1024 / 256, 256, 0, stream>>>(glu, ys5);
            k_sc_pre<<<L * 512 / 256, 256, 0, stream>>>(p, DIN, L, sc_conv_w + l * 1536, scA);
            gemm(scA, 512, sc_out_w + (size_t)l * 512 * 1024, 1024, scO, 1024, L, 1024, 512);
            k_hy_pre<<<L * 1536 / 256, 256, 0, stream>>>(p, DIN, L, hy_conv_w + l * 4608, hy_conv_b + l * 1536, q);
            k_hy_u<<<L * 512 / 256, 256, 0, stream>>>(q, u);
            k_hy_conv<<<dim3(L / 64, 8), 256, 0, stream>>>(u, kb, hy_d + l * 512, q, L, hyA);
            gemm(hyA, 512, hy_out_w + (size_t)l * 512 * 1024, 1024, hyO, 1024, L, 1024, 512);
            k_merge<<<L * 1024 / 256, 256, 0, stream>>>(p, DIN, ys5, scO, hyO, m);
            gemm(m, D, out_w + (size_t)l * D * D, D, tmp, D, L, D, D);
            k_resid<<<L * 1024 / 256, 256, 0, stream>>>(xb, modv + 2048, tmp);
            k_norm_mod<<<L, 256, 0, stream>>>(xb, norm2_g + l * D, modv + 3072, modv + 4096, h);
            gemm(h, D, mlp_w1 + (size_t)l * D * DFF, DFF, p, DFF, L, DFF, D);
            k_relu2<<<L * DFF / 256, 256, 0, stream>>>(p);
            gemm(p, DFF, mlp_w2 + (size_t)l * DFF * D, D, tmp, D, L, D, DFF);
            k_resid<<<L * 1024 / 256, 256, 0, stream>>>(xb, modv + 5120, tmp);
        };
        const float* modl = mod + (size_t)l * 5 * NMOD;
        for (int b = 0; b < NB; ++b) block(xc + (size_t)b * CTX * D, CTX, modl + 4 * NMOD, nullptr, fin + (size_t)b * 8192, !last, kC);
        for (int b = 0; b < NB; ++b) block(xs + (size_t)b * SEQ * D, SEQ, modl + (size_t)b * NMOD, fin + (size_t)b * 8192, fin2, true, kL);
    }
    k_norm_mod<<<NB * SEQ, 256, 0, stream>>>(xs, final_g, nullptr, nullptr, xs);
}
```

```cpp
#include <hip/hip_runtime.h>
#include <cstdio>
#include <cstdint>

#ifndef MK_PER_PHASE
#define MK_PER_PHASE 0
#endif

#define LAS __attribute__((address_space(3)))
#define GAS __attribute__((address_space(1)))
typedef unsigned short bf16_t;
typedef short bf16x8 __attribute__((ext_vector_type(8)));
typedef float f32x4 __attribute__((ext_vector_type(4)));
typedef float f32x2 __attribute__((ext_vector_type(2)));
typedef unsigned u32x4 __attribute__((ext_vector_type(4)));
typedef unsigned u32x2 __attribute__((ext_vector_type(2)));
typedef GAS unsigned gu32;

namespace pg8 {
constexpr int BM = 256, BK = 64, HALF = 128, HTB = HALF * BK * 2, STAGE_BYTES = 8 * HTB, NXCD = 8, WGM = 8;
__host__ __device__ __forceinline__ int lds_byte(int r, int c) { const int st = (r >> 4) * 2 + (c >> 5), rr = r & 15, cc = c & 31, ob = rr * 64 + cc * 2; return st * 1024 + (ob ^ (((ob >> 9) & 1) << 5)); }
__host__ __device__ __forceinline__ void stage_rc(int b, int& R, int& C) { const int st = b / 1024, sb = b % 1024, swz = sb ^ (((sb >> 9) & 1) << 5); R = (st >> 1) * 16 + swz / 64; C = (st & 1) * 32 + (swz % 64) / 2; }
__host__ __device__ __forceinline__ int perm32(int rho) { const int n = rho >> 4, i = rho & 15; return 8 * (i >> 2) + 4 * n + (i & 3); }

struct Unit { int pm, pn, g; const char* A; const char* B; };
struct GemmP { int lda, ldb, K; };

struct GridOrder {
    int nM, nN, nG, nEM, nEN, nmain, nwg, G, c;
    int pm0, pn0, epm0;
    const char* A; const char* B; size_t tA, tB, gA, gB;
    __device__ __forceinline__ void init(int nG_, int nM_, int nN_, int G_, int c_, const void* A_, size_t tA_, size_t gA_, const void* B_, size_t tB_, size_t gB_) {
        nG = nG_; nM = nM_; nN = nN_; nEM = 0; nEN = 0; nmain = nG * nM * nN; nwg = nmain; G = G_; c = c_; pm0 = 0; pn0 = 0; epm0 = 0;
        A = (const char*)A_; B = (const char*)B_; tA = tA_; tB = tB_; gA = gA_; gB = gB_;
    }
    __device__ __forceinline__ void extra(int nEM_, int nEN_, int epm0_) { nEM = nEM_; nEN = nEN_; epm0 = epm0_; nwg = nmain + nEM * nEN; }
    __device__ __forceinline__ bool next(int i, Unit& u) const {
        const long L = (long)i * G + c; if (L >= nwg) return false;
        int pm, pn, g = 0;
        if (L >= nmain) { const int e = (int)L - nmain; pm = epm0 + e / nEN; pn = pn0 + e % nEN; }
        else {
            int wgid = (int)L; { const int q = nmain / NXCD, r = nmain % NXCD, xcd = wgid % NXCD, off = wgid / NXCD; wgid = (xcd < r ? xcd * (q + 1) : r * (q + 1) + (xcd - r) * q) + off; }
            const int per = nM * nN; g = wgid / per; const int w = wgid % per;
            const int nig = WGM * nN, gid = w / nig, fm = gid * WGM, gsz = (nM - fm) < WGM ? (nM - fm) : WGM;
            pm = pm0 + fm + ((w % nig) % gsz); pn = pn0 + (w % nig) / gsz;
        }
        u.pm = pm; u.pn = pn; u.g = g; u.A = A + (size_t)g * gA + (size_t)pm * tA; u.B = B + (size_t)g * gB + (size_t)pn * tB; return true;
    }
};
struct GluOrder {
    GridOrder base; const char* B; size_t tB;
    __device__ __forceinline__ bool next(int i, Unit& u) const {
        Unit b; if (!base.next(i >> 1, b)) return false;
        u.pm = b.pm; u.pn = 2 * b.pn + (i & 1); u.g = 0; u.A = b.A; u.B = B + (size_t)u.pn * tB; return true;
    }
};

__device__ __forceinline__ unsigned cvt_pk_bf16(float lo, float hi) { unsigned r; asm volatile("v_cvt_pk_bf16_f32 %0, %1, %2" : "=v"(r) : "v"(lo), "v"(hi)); return r; }

template <class Epi, class Sched>
__device__ __forceinline__ void gemm_phase(LAS unsigned char* lds, const GemmP g, const Sched& S, const Epi& E) {
    int tid_ = threadIdx.x; asm volatile("" : "+v"(tid_));
    const int tid = tid_, wid = __builtin_amdgcn_readfirstlane(tid >> 6), lane = tid & 63, wr = wid >> 2, wc = wid & 3, fr = lane & 15, fq = lane >> 4;
    const int nt = g.K / BK;
    unsigned voffA[2], voffB[2];
#pragma unroll
    for (int i = 0; i < 2; ++i) { int R, C; stage_rc(tid * 16 + i * 8192, R, C); const int Rb = Epi::PERM ? ((R & ~31) + perm32(R & 31)) : R;
        voffA[i] = (unsigned)(R * g.lda + C) * 2u; voffB[i] = (unsigned)(Rb * g.ldb + C) * 2u; }
    const size_t kstep = (size_t)(BK * 2);
    const size_t hstepA = (size_t)HALF * g.lda * 2, hstepB = (size_t)HALF * g.ldb * 2;
    const unsigned ldsw = (unsigned)wid * 1024u;
    const int aoff = lds_byte(wr * 64 + fr, fq * 8), boff = lds_byte(wc * 32 + fr, fq * 8);
#define PG8_SA(b, h) (((b) * 2 + (h)) * HTB)
#define PG8_SB(b, h) ((4 + (b) * 2 + (h)) * HTB)
#define PG8_STAGE(bufoff, gbase, voff) do { _Pragma("unroll") for (int _i = 0; _i < 2; ++_i) \
        __builtin_amdgcn_global_load_lds((const unsigned*)((const char*)(gbase) + (voff)[_i]), (LAS unsigned*)(lds + (bufoff) + ldsw + _i * 8192), 16, 0, 0); } while (0)
#define PG8_LDA(dst, b, h) do { _Pragma("unroll") for (int m = 0; m < 4; ++m) _Pragma("unroll") for (int k = 0; k < 2; ++k) dst[m][k] = *(const LAS bf16x8*)(lds + PG8_SA(b, h) + aoff + m * 2048 + k * 1024); } while (0)
#define PG8_LDB(dst, b, h) do { _Pragma("unroll") for (int n = 0; n < 2; ++n) _Pragma("unroll") for (int k = 0; k < 2; ++k) dst[n][k] = *(const LAS bf16x8*)(lds + PG8_SB(b, h) + boff + n * 2048 + k * 1024); } while (0)
#define PG8_MMA(ai, bj, At, Bt) do { __builtin_amdgcn_s_setprio(1); _Pragma("unroll") for (int m = 0; m < 4; ++m) _Pragma("unroll") for (int n = 0; n < 2; ++n) _Pragma("unroll") for (int k = 0; k < 2; ++k) \
        acc[ai][bj][m][n] = __builtin_amdgcn_mfma_f32_16x16x32_bf16(Bt[n][k], At[m][k], acc[ai][bj][m][n], 0, 0, 0); __builtin_amdgcn_s_setprio(0); } while (0)
#define PG8_WAIT_V(n) asm volatile("s_waitcnt vmcnt(" #n ")" ::: "memory")
#define PG8_WAIT_L(n) asm volatile("s_waitcnt lgkmcnt(" #n ")" ::: "memory")
#define PG8_BAR __builtin_amdgcn_s_barrier()
#define PG8_SCHED __builtin_amdgcn_sched_barrier(0)
    Unit cur, nxt; int ui = 0;
    if (!S.next(0, cur)) return;
    f32x4 acc[2][2][4][2];
#pragma unroll
    for (int a = 0; a < 2; ++a)
#pragma unroll
        for (int b = 0; b < 2; ++b)
#pragma unroll
            for (int m = 0; m < 4; ++m)
#pragma unroll
                for (int n = 0; n < 2; ++n) acc[a][b][m][n] = (f32x4){0.f, 0.f, 0.f, 0.f};
    bf16x8 At[4][2], B0[2][2], B1[2][2];
    const char* cA = cur.A; const char* cB = cur.B;
    PG8_STAGE(PG8_SB(0, 0), cB, voffB); PG8_STAGE(PG8_SB(0, 1), cB + hstepB, voffB); PG8_STAGE(PG8_SA(0, 0), cA, voffA); PG8_STAGE(PG8_SA(0, 1), cA + hstepA, voffA);
    if (wr == 1) PG8_BAR;
    PG8_WAIT_V(2); PG8_BAR;
    PG8_STAGE(PG8_SB(1, 0), cB + kstep, voffB); PG8_STAGE(PG8_SA(1, 0), cA + kstep, voffA); PG8_STAGE(PG8_SB(1, 1), cB + hstepB + kstep, voffB);
    PG8_WAIT_V(6); PG8_BAR;
    for (;;) {
        const bool has_next = S.next(ui + 1, nxt);
        const char* nA = has_next ? nxt.A : cA; const char* nB = has_next ? nxt.B : cB;
        for (int t = 0; t < nt; t += 2) {
            const bool last = (t == nt - 2);
            const char* a1 = cA + (size_t)(t + 1) * kstep;
            const char* a2 = last ? nA : cA + (size_t)(t + 2) * kstep; const char* b2 = last ? nB : cB + (size_t)(t + 2) * kstep;
            const char* a3 = a2 + kstep; const char* b3 = b2 + kstep;
            PG8_LDB(B0, 0, 0); PG8_LDB(B1, 0, 1); PG8_SCHED; PG8_LDA(At, 0, 0); PG8_STAGE(PG8_SA(1, 1), a1 + hstepA, voffA);
            PG8_WAIT_V(8); PG8_WAIT_L(0); PG8_BAR; PG8_MMA(0, 0, At, B0); PG8_MMA(0, 1, At, B1); PG8_BAR; PG8_SCHED;
            PG8_LDA(At, 0, 1); PG8_STAGE(PG8_SB(0, 0), b2, voffB); PG8_STAGE(PG8_SB(0, 1), b2 + hstepB, voffB); PG8_STAGE(PG8_SA(0, 0), a2, voffA);
            PG8_WAIT_V(8); PG8_WAIT_L(0); PG8_BAR; PG8_MMA(1, 0, At, B0); PG8_MMA(1, 1, At, B1); PG8_BAR; PG8_SCHED;
            PG8_LDB(B0, 1, 0); PG8_LDB(B1, 1, 1); PG8_SCHED; PG8_LDA(At, 1, 0); PG8_STAGE(PG8_SA(0, 1), a2 + hstepA, voffA);
            PG8_WAIT_V(8); PG8_WAIT_L(0); PG8_BAR; PG8_MMA(0, 0, At, B0); PG8_MMA(0, 1, At, B1); PG8_BAR; PG8_SCHED;
            PG8_LDA(At, 1, 1); PG8_STAGE(PG8_SB(1, 0), b3, voffB); PG8_STAGE(PG8_SB(1, 1), b3 + hstepB, voffB); PG8_STAGE(PG8_SA(1, 0), a3, voffA);
            PG8_WAIT_V(8); PG8_WAIT_L(0); PG8_BAR; PG8_MMA(1, 0, At, B0); PG8_MMA(1, 1, At, B1); PG8_BAR; PG8_SCHED;
        }
        if (wr == 0) PG8_BAR;
        E(acc, cur, wr, wc, fr, fq);
        if (!has_next) break;
#pragma unroll
        for (int a = 0; a < 2; ++a)
#pragma unroll
            for (int b = 0; b < 2; ++b)
#pragma unroll
                for (int m = 0; m < 4; ++m)
#pragma unroll
                    for (int n = 0; n < 2; ++n) acc[a][b][m][n] = (f32x4){0.f, 0.f, 0.f, 0.f};
        cur = nxt; cA = nA; cB = nB; ++ui;
        if (wr == 1) PG8_BAR;
    }
    PG8_WAIT_V(0);
    PG8_BAR;
#undef PG8_SA
#undef PG8_SB
#undef PG8_STAGE
#undef PG8_LDA
#undef PG8_LDB
#undef PG8_MMA
#undef PG8_WAIT_V
#undef PG8_WAIT_L
#undef PG8_BAR
#undef PG8_SCHED
}
}
namespace mk {
constexpr int NWAVES = 8, NTHREADS = 512;
constexpr int D = 1024, NB = 4, SEQ = 4096, CTXL = 256, DFF = 4096, NMOD = 6144;
constexpr int ML = NB * SEQ, MC = NB * CTXL, MALL = ML + MC;
constexpr int TCH = 32, NCHL = SEQ / TCH, NCHC = CTXL / TCH, UROWS = NB * NCHL + NB * NCHC;
constexpr int UAK = 768;
constexpr float EPS = 1e-6f;

constexpr size_t al(size_t x) { return (x + 255) & ~(size_t)255; }
constexpr size_t WS_CTL = 0, CTL_BYTES = 1u << 20;
constexpr size_t WS_MOD = WS_CTL + CTL_BYTES;
constexpr size_t WS_POS = al(WS_MOD + (size_t)2 * 5 * NMOD * 4);
constexpr size_t WS_H3 = al(WS_POS + 64 * 512 * 4);
constexpr size_t WS_H3C = al(WS_H3 + (size_t)SEQ * 64 * 4);
constexpr size_t WS_KINV = al(WS_H3C + (size_t)CTXL * 64 * 4);
constexpr size_t WS_APOW = al(WS_KINV + 1024 * 4);
constexpr size_t WS_WIN = al(WS_APOW + 32 * 2 * 64 * 2 * 4);
constexpr size_t WS_WGLU = al(WS_WIN + (size_t)6656 * 1024 * 2);
constexpr size_t WS_WSC = al(WS_WGLU + (size_t)2048 * 512 * 2);
constexpr size_t WS_WHY = al(WS_WSC + (size_t)1024 * 512 * 2);
constexpr size_t WS_WOUT = al(WS_WHY + (size_t)1024 * 512 * 2);
constexpr size_t WS_W1 = al(WS_WOUT + (size_t)1024 * 1024 * 2);
constexpr size_t WS_W2 = al(WS_W1 + (size_t)4096 * 1024 * 2);
constexpr size_t WS_BTB = al(WS_W2 + (size_t)1024 * 4096 * 2);
constexpr size_t WS_WST = al(WS_BTB + (size_t)32 * 512 * 768 * 2);
constexpr size_t WS_H = al(WS_WST + (size_t)32 * 256 * 512 * 2);
constexpr size_t WS_XC = al(WS_H + (size_t)MALL * 1024 * 2);
constexpr size_t WS_SEC = al(WS_XC + (size_t)MC * 1024 * 4);
constexpr size_t WS_PBUF = WS_SEC;
constexpr size_t WS_YPRE = WS_PBUF;
constexpr size_t WS_GATE = al(WS_PBUF + (size_t)MALL * 512 * 2);
constexpr size_t WS_UA = al(WS_PBUF + (size_t)MALL * 1536 * 2);
constexpr size_t WS_SLOC = al(WS_UA + (size_t)(32 * UROWS + 256) * UAK * 2);
constexpr size_t WS_KT = WS_SLOC;
constexpr size_t WS_M = WS_UA;
constexpr size_t WS_SCA = al(WS_SLOC + (size_t)32 * UROWS * 256 * 4);
constexpr size_t WS_X0 = al(WS_SCA + (size_t)MALL * 512 * 2);
constexpr size_t WS_UT = al(WS_X0 + (size_t)MALL * 512 * 2);
constexpr size_t WS_UTC = al(WS_UT + (size_t)512 * ML * 2);
constexpr size_t WS_KTC = al(WS_UTC + (size_t)512 * MC * 2);
constexpr size_t WS_SEC_END = al(WS_KTC + (size_t)512 * 512 * 4);
constexpr size_t WS_R = WS_SEC;
constexpr size_t WS_END = WS_SEC_END;
static_assert(WS_M + (size_t)MALL * 1024 * 2 <= WS_SCA, "m overlays UA|SLOC");
static_assert(WS_KT + (size_t)512 * 8192 * 4 <= WS_SCA, "kT overlays SLOC");
static_assert(WS_R + (size_t)MALL * 4096 * 2 <= WS_SEC_END, "r overlays the section");
static_assert(WS_GATE + (size_t)MALL * 1024 * 2 <= WS_UA, "gate inside PBUF");

constexpr int RING_BYTES = 131072;
constexpr int LDSCTL_OFF = 139264, MISC_OFF = LDSCTL_OFF + 320;
constexpr int LDS_BYTES = 147456;

constexpr int CW_BAR = 4096;
#define XB_TMO      128
#define XB_XCNT(j)  (256  + 64 * (j))
#define XB_XSUB(j)  (1280 + 64 * (j))
#define XB_XGEN(j)  (2304 + 64 * (j))
#define XB_TOP      3328
#define XB_TOPGEN   3392
#define XCD_BAR_WORDS 3456
#define XB_SPIN_CAP (1u << 18)

__device__ __forceinline__ unsigned xb_ld(unsigned* p)              { return __hip_atomic_load(p, __ATOMIC_RELAXED, __HIP_MEMORY_SCOPE_AGENT); }
__device__ __forceinline__ unsigned xb_add(unsigned* p, unsigned v) { return __hip_atomic_fetch_add(p, v, __ATOMIC_RELAXED, __HIP_MEMORY_SCOPE_AGENT); }
__device__ __forceinline__ unsigned xb_xcc_id() { return (unsigned)__builtin_amdgcn_s_getreg((3 << 11) | 20) & 0xFu; }
#define XB_SPIN(cond, bar) do { unsigned _sp = 0; while (cond) { __builtin_amdgcn_s_sleep(1); \
    if ((++_sp & 255u) == 0u) { if (xb_ld(&(bar)[XB_TMO])) break; if (_sp > XB_SPIN_CAP) { atomicAdd(&(bar)[XB_TMO], 1u); break; } } } } while (0)
struct XcdBarrier { unsigned* bar; unsigned x; volatile LAS unsigned* st; };
__device__ __forceinline__ XcdBarrier xcd_barrier_post(unsigned* bar, volatile LAS unsigned* st) {
    XcdBarrier b; b.bar = bar; b.x = xb_xcc_id(); b.st = st;
    if (threadIdx.x == 0) (void)xb_add(&bar[XB_XCNT(b.x)], 1u);
    return b;
}
__device__ __forceinline__ void xcd_barrier_complete(unsigned* bar, unsigned x, unsigned& nloc, unsigned& nx) {
    const unsigned G = gridDim.x * gridDim.y * gridDim.z;
    unsigned sum, cnt, mine, sp = 0u;
    for (;;) {
        sum = 0u; cnt = 0u; mine = 0u;
#pragma unroll
        for (unsigned j = 0; j < 16; ++j) { const unsigned c = xb_ld(&bar[XB_XCNT(j)]); sum += c; cnt += (c > 0u) ? 1u : 0u; mine = (j == x) ? c : mine; }
        if (sum == G) break;
        __builtin_amdgcn_s_sleep(1);
        if ((++sp & 255u) == 0u) { if (xb_ld(&bar[XB_TMO])) break; if (sp > XB_SPIN_CAP) { atomicAdd(&bar[XB_TMO], 1u); break; } }
    }
    nloc = mine > 0u ? mine : 1u; nx = cnt > 0u ? cnt : 1u;
}
__device__ __forceinline__ void xcd_barrier(const XcdBarrier& b) {
    asm volatile("s_waitcnt vmcnt(0)" ::: "memory");
    __syncthreads();
    if (threadIdx.x == 0) {
        unsigned* bar = b.bar;
        __builtin_amdgcn_s_waitcnt(0);
        unsigned nloc = b.st[0], nx = b.st[1];
        if (nloc == 0u) { xcd_barrier_complete(bar, b.x, nloc, nx); b.st[0] = nloc; b.st[1] = nx; }
        const unsigned old = xb_add(&bar[XB_XSUB(b.x)], 1u);
        const unsigned gen = old / nloc;
        if (old + 1u == (gen + 1u) * nloc) {
            __builtin_amdgcn_fence(__ATOMIC_RELEASE, "agent");
            asm volatile("s_waitcnt vmcnt(0)" ::: "memory");
            const unsigned og = xb_add(&bar[XB_TOP], 1u);
            const unsigned tg = og / nx;
            if (og + 1u == (tg + 1u) * nx) xb_add(&bar[XB_TOPGEN], 1u);
            else XB_SPIN(xb_ld(&bar[XB_TOPGEN]) == tg, bar);
            __builtin_amdgcn_fence(__ATOMIC_ACQUIRE, "agent");
            xb_add(&bar[XB_XGEN(b.x)], 1u);
            asm volatile("s_waitcnt vmcnt(0)" ::: "memory");
        } else {
            XB_SPIN(xb_ld(&bar[XB_XGEN(b.x)]) == gen, bar);
            __builtin_amdgcn_fence(__ATOMIC_ACQUIRE, "agent");
            asm volatile("s_waitcnt vmcnt(0)" ::: "memory");
        }
    }
    __syncthreads();
}

#define LDS_WAIT() asm volatile("s_waitcnt lgkmcnt(0)" ::: "memory")
#define VM_WAIT() asm volatile("s_waitcnt vmcnt(0)" ::: "memory")
__device__ __forceinline__ unsigned f2bf(float f) { unsigned u = __builtin_bit_cast(unsigned, f); return (u + 0x7fffu + ((u >> 16) & 1u)) >> 16; }
__device__ __forceinline__ unsigned pk2(float lo, float hi) { return f2bf(lo) | (f2bf(hi) << 16); }
__device__ __forceinline__ float bflo(unsigned w) { return __builtin_bit_cast(float, w << 16); }
__device__ __forceinline__ float bfhi(unsigned w) { return __builtin_bit_cast(float, w & 0xffff0000u); }
__device__ __forceinline__ float bf1(bf16_t h) { return __builtin_bit_cast(float, (unsigned)h << 16); }
__device__ __forceinline__ float sigm(float x) { return 1.f / (1.f + __expf(-x)); }
__device__ __forceinline__ float gelu_tanh(float x) { const float u = 0.7978845608028654f * (x + 0.044715f * x * x * x); const float e = __expf(2.f * u); return x * (1.f - 1.f / (1.f + e)); }
__device__ __forceinline__ float wave_sum(float v) {
#pragma unroll
    for (int o = 1; o < 64; o <<= 1) v += __shfl_xor(v, o);
    return v;
}

struct Args {
    const float* in[36]; float* out; unsigned char* ws; int ph_lo, ph_hi;
};
struct Frame {
    LAS unsigned char* lds; int tid, lane, wave, G, bid, gw, ngw;
    const float* const __attribute__((address_space(4)))* in; float* out; unsigned char* ws;
};
__device__ __forceinline__ float* xrow(const Frame& F, int row) { return row < ML ? F.out + (size_t)row * D : (float*)(F.ws + WS_XC) + (size_t)(row - ML) * D; }
__device__ __forceinline__ int modrow(int row) { return row < ML ? (row >> 12) : 4; }
__device__ __forceinline__ void urow_of(int row, int& ur, int& i) {
    if (row < ML) { ur = (row >> 12) * NCHL + ((row & 4095) >> 5); i = row & 31; }
    else { const int rc = row - ML; ur = NB * NCHL + (rc >> 8) * NCHC + ((rc & 255) >> 5); i = rc & 31; }
}
__device__ __forceinline__ int tok_of_urow(int ur) { return ur < NB * NCHL ? (ur >> 7) * SEQ + (ur & 127) * TCH : ML + ((ur - NB * NCHL) >> 3) * CTXL + ((ur - NB * NCHL) & 7) * TCH; }
using pg8::Unit;
using pg8::cvt_pk_bf16;
typedef f32x4 AccT[2][2][4][2];

__device__ __forceinline__ u32x4 pack8(const f32x4 v0, const f32x4 v1) { u32x4 w; w.x = cvt_pk_bf16(v0[0], v0[1]); w.y = cvt_pk_bf16(v0[2], v0[3]); w.z = cvt_pk_bf16(v1[0], v1[1]); w.w = cvt_pk_bf16(v1[2], v1[3]); return w; }

struct EpiBf16 {
    static constexpr bool PERM = true; bf16_t* O; int ldc;
    __device__ __forceinline__ void operator()(const AccT& acc, const Unit& u, int wr, int wc, int fr, int fq) const {
        const int row0 = u.pm * 256 + wr * 64 + fr, col0 = u.pn * 256 + wc * 32 + 8 * fq;
#pragma unroll
        for (int ai = 0; ai < 2; ++ai)
#pragma unroll
            for (int m = 0; m < 4; ++m) { bf16_t* rowp = O + (size_t)(row0 + ai * 128 + m * 16) * ldc + col0;
#pragma unroll
                for (int bj = 0; bj < 2; ++bj) *(u32x4*)(rowp + bj * 128) = pack8(acc[ai][bj][m][0], acc[ai][bj][m][1]); }
    }
};
struct EpiWinA {
    static constexpr bool PERM = true; bf16_t* UA; bf16_t* P;
    __device__ __forceinline__ void operator()(const AccT& acc, const Unit& u, int wr, int wc, int fr, int fq) const {
        const int row0 = u.pm * 256 + wr * 64 + fr;
        if (u.pn >= 2) {
            const int col0 = (u.pn - 2) * 256 + wc * 32 + 8 * fq;
#pragma unroll
            for (int ai = 0; ai < 2; ++ai)
#pragma unroll
                for (int m = 0; m < 4; ++m) { bf16_t* rowp = P + (size_t)(row0 + ai * 128 + m * 16) * 1536 + col0;
#pragma unroll
                    for (int bj = 0; bj < 2; ++bj) *(u32x4*)(rowp + bj * 128) = pack8(acc[ai][bj][m][0], acc[ai][bj][m][1]); }
        } else {
            const int q0 = 8 * (fq & 1), gb = 16 * u.pn + 2 * wc + (fq >> 1);
#pragma unroll
            for (int ai = 0; ai < 2; ++ai)
#pragma unroll
                for (int m = 0; m < 4; ++m) { int ur, i; urow_of(row0 + ai * 128 + m * 16, ur, i);
#pragma unroll
                    for (int bj = 0; bj < 2; ++bj) { const int g = gb + 8 * bj;
                        *(u32x4*)(UA + ((size_t)g * UROWS + ur) * UAK + i * 16 + q0) = pack8(acc[ai][bj][m][0], acc[ai][bj][m][1]); } }
        }
    }
};
struct EpiSloc {
    static constexpr bool PERM = false; float* S;
    __device__ __forceinline__ void operator()(const AccT& acc, const Unit& u, int wr, int wc, int fr, int fq) const {
        const int row0 = u.pm * 256 + wr * 64 + fr, col0 = wc * 32 + 4 * fq;
#pragma unroll
        for (int ai = 0; ai < 2; ++ai)
#pragma unroll
            for (int m = 0; m < 4; ++m) { const int r = row0 + ai * 128 + m * 16; if (r < UROWS) { float* rowp = S + ((size_t)u.g * UROWS + r) * 256 + col0;
#pragma unroll
                for (int bj = 0; bj < 2; ++bj)
#pragma unroll
                    for (int n = 0; n < 2; ++n) *(f32x4*)(rowp + bj * 128 + n * 16) = acc[ai][bj][m][n]; } }
    }
};
struct EpiYpre {
    static constexpr bool PERM = true; bf16_t* Y;
    __device__ __forceinline__ void operator()(const AccT& acc, const Unit& u, int wr, int wc, int fr, int fq) const {
        const int row0 = u.pm * 256 + wr * 64 + fr, p0 = 8 * (fq & 1), jb = 16 * u.pn + 2 * wc + (fq >> 1);
#pragma unroll
        for (int ai = 0; ai < 2; ++ai)
#pragma unroll
            for (int m = 0; m < 4; ++m) { const int r = row0 + ai * 128 + m * 16; if (r < UROWS) { const int tok0 = tok_of_urow(r);
#pragma unroll
                for (int bj = 0; bj < 2; ++bj) { const int j = jb + 8 * bj; f32x4 v0 = acc[ai][bj][m][0], v1 = acc[ai][bj][m][1];
#pragma unroll
                    for (int e = 0; e < 4; ++e) { v0[e] = gelu_tanh(v0[e]); v1[e] = gelu_tanh(v1[e]); }
                    *(u32x4*)(Y + (size_t)(tok0 + j) * 512 + u.g * 16 + p0) = pack8(v0, v1); } } }
    }
};
struct EpiGate {
    static constexpr bool PERM = true; bf16_t* O;
    __device__ __forceinline__ void operator()(const AccT& acc, const Unit& u, int wr, int wc, int fr, int fq) const {
        const int row0 = u.pm * 256 + wr * 64 + fr, col0 = u.pn * 256 + wc * 32 + 8 * fq;
#pragma unroll
        for (int ai = 0; ai < 2; ++ai)
#pragma unroll
            for (int m = 0; m < 4; ++m) { bf16_t* rowp = O + (size_t)(row0 + ai * 128 + m * 16) * 1024 + col0;
#pragma unroll
                for (int bj = 0; bj < 2; ++bj) { f32x4 v0 = acc[ai][bj][m][0], v1 = acc[ai][bj][m][1];
#pragma unroll
                    for (int e = 0; e < 4; ++e) { v0[e] = sigm(v0[e]); v1[e] = sigm(v1[e]); }
                    *(u32x4*)(rowp + bj * 128) = pack8(v0, v1); } }
    }
};
__device__ __forceinline__ void unpack8(const u32x4 w, f32x4& a, f32x4& b) { a = (f32x4){bflo(w.x), bfhi(w.x), bflo(w.y), bfhi(w.y)}; b = (f32x4){bflo(w.z), bfhi(w.z), bflo(w.w), bfhi(w.w)}; }
template <int MODE> struct EpiBranch {
    static constexpr bool PERM = true; bf16_t* M; const bf16_t* Gt;
    __device__ __forceinline__ void operator()(const AccT& acc, const Unit& u, int wr, int wc, int fr, int fq) const {
        const int row0 = u.pm * 256 + wr * 64 + fr;
        if (MODE == 0) {
            const int col0 = u.pn * 128 + wc * 32 + 8 * fq;
#pragma unroll
            for (int ai = 0; ai < 2; ++ai)
#pragma unroll
                for (int m = 0; m < 4; ++m) { const size_t o = (size_t)(row0 + ai * 128 + m * 16) * 1024 + col0;
                    f32x4 g0, g1; unpack8(*(const u32x4*)(Gt + o), g0, g1);
                    f32x4 v0 = acc[ai][0][m][0], v1 = acc[ai][0][m][1]; const f32x4 s0 = acc[ai][1][m][0], s1 = acc[ai][1][m][1];
#pragma unroll
                    for (int e = 0; e < 4; ++e) { v0[e] = g0[e] * v0[e] * sigm(s0[e]); v1[e] = g1[e] * v1[e] * sigm(s1[e]); }
                    *(u32x4*)(M + o) = pack8(v0, v1); }
        } else {
            const int col0 = u.pn * 256 + wc * 32 + 8 * fq;
#pragma unroll
            for (int ai = 0; ai < 2; ++ai)
#pragma unroll
                for (int m = 0; m < 4; ++m)
#pragma unroll
                    for (int bj = 0; bj < 2; ++bj) { const size_t o = (size_t)(row0 + ai * 128 + m * 16) * 1024 + col0 + bj * 128;
                        f32x4 g0, g1, m0, m1; unpack8(*(const u32x4*)(Gt + o), g0, g1); unpack8(*(const u32x4*)(M + o), m0, m1);
                        const f32x4 v0 = m0 + g0 * acc[ai][bj][m][0], v1 = m1 + g1 * acc[ai][bj][m][1];
                        *(u32x4*)(M + o) = pack8(v0, v1); }
        }
    }
};
struct EpiResid {
    static constexpr bool PERM = false; float* xl; float* xc; const float* gm;
    __device__ __forceinline__ void operator()(const AccT& acc, const Unit& u, int wr, int wc, int fr, int fq) const {
        const int rt = u.pm * 256; float* base = rt < ML ? xl + (size_t)rt * 1024 : xc + (size_t)(rt - ML) * 1024;
        const float* gv = gm + (size_t)(rt < ML ? (rt >> 12) : 4) * NMOD;
        const int rl = wr * 64 + fr, col0 = u.pn * 256 + wc * 32 + 4 * fq;
        f32x4 gg[2][2];
#pragma unroll
        for (int bj = 0; bj < 2; ++bj)
#pragma unroll
            for (int n = 0; n < 2; ++n) gg[bj][n] = *(const f32x4*)(gv + col0 + bj * 128 + n * 16);
#pragma unroll
        for (int ai = 0; ai < 2; ++ai)
#pragma unroll
            for (int m = 0; m < 4; ++m) { float* rowp = base + (size_t)(rl + ai * 128 + m * 16) * 1024 + col0;
#pragma unroll
                for (int bj = 0; bj < 2; ++bj)
#pragma unroll
                    for (int n = 0; n < 2; ++n) { f32x4* p = (f32x4*)(rowp + bj * 128 + n * 16); *p = *p + gg[bj][n] * acc[ai][bj][m][n]; } }
    }
};
struct EpiRelu2 {
    static constexpr bool PERM = true; bf16_t* O;
    __device__ __forceinline__ void operator()(const AccT& acc, const Unit& u, int wr, int wc, int fr, int fq) const {
        const int row0 = u.pm * 256 + wr * 64 + fr, col0 = u.pn * 256 + wc * 32 + 8 * fq;
#pragma unroll
        for (int ai = 0; ai < 2; ++ai)
#pragma unroll
            for (int m = 0; m < 4; ++m) { bf16_t* rowp = O + (size_t)(row0 + ai * 128 + m * 16) * 4096 + col0;
#pragma unroll
                for (int bj = 0; bj < 2; ++bj) { f32x4 v0 = acc[ai][bj][m][0], v1 = acc[ai][bj][m][1];
#pragma unroll
                    for (int e = 0; e < 4; ++e) { const float a = fmaxf(v0[e], 0.f), b = fmaxf(v1[e], 0.f); v0[e] = a * a; v1[e] = b * b; }
                    *(u32x4*)(rowp + bj * 128) = pack8(v0, v1); } }
    }
};
#define FFT_HD __device__ __forceinline__
typedef float cf __attribute__((ext_vector_type(2)));
FFT_HD cf cadd(cf a, cf b) { return a + b; }
FFT_HD cf csub(cf a, cf b) { return a - b; }
FFT_HD cf cmul(cf a, cf b) { return (cf){a.x * b.x - a.y * b.y, a.x * b.y + a.y * b.x}; }
FFT_HD cf cmulmi(cf a) { return (cf){a.y, -a.x}; }
FFT_HD void dft4(cf& a0, cf& a1, cf& a2, cf& a3) {
    const cf t0 = cadd(a0, a2), t1 = csub(a0, a2), t2 = cadd(a1, a3), t3 = cmulmi(csub(a1, a3));
    a0 = cadd(t0, t2); a2 = csub(t0, t2); a1 = cadd(t1, t3); a3 = csub(t1, t3);
}
FFT_HD void dft8(cf* v) {
    cf e0 = v[0], e1 = v[2], e2 = v[4], e3 = v[6], o0 = v[1], o1 = v[3], o2 = v[5], o3 = v[7];
    dft4(e0, e1, e2, e3); dft4(o0, o1, o2, o3);
    const float h = 0.70710678118654752f;
    const cf w1o = (cf){h * (o1.x + o1.y), h * (o1.y - o1.x)};
    const cf w2o = cmulmi(o2);
    const cf w3o = (cf){h * (o3.y - o3.x), -h * (o3.x + o3.y)};
    v[0] = cadd(e0, o0); v[4] = csub(e0, o0);
    v[1] = cadd(e1, w1o); v[5] = csub(e1, w1o);
    v[2] = cadd(e2, w2o); v[6] = csub(e2, w2o);
    v[3] = cadd(e3, w3o); v[7] = csub(e3, w3o);
}
FFT_HD void dft16(cf* v) {
    cf e[8], o[8];
#pragma unroll
    for (int i = 0; i < 8; ++i) { e[i] = v[2 * i]; o[i] = v[2 * i + 1]; }
    dft8(e); dft8(o);
    const float c1 = 0.92387953251128674f, s1 = 0.38268343236508977f, h = 0.70710678118654752f;
    const cf w[8] = {(cf){1.f, 0.f}, (cf){c1, -s1}, (cf){h, -h}, (cf){s1, -c1}, (cf){0.f, -1.f}, (cf){-s1, -c1}, (cf){-h, -h}, (cf){-c1, -s1}};
#pragma unroll
    for (int k = 0; k < 8; ++k) { const cf t = cmul(o[k], w[k]); v[k] = cadd(e[k], t); v[k + 8] = csub(e[k], t); }
}
template <int R, int LOGS, int LOGN> __device__ __forceinline__ void fft_pass(LAS cf* buf, const LAS cf* tw, int tid) {
    constexpr int NBF = 8192 / R, BPT = NBF / NTHREADS;
    cf v[BPT][R];
#pragma unroll
    for (int b = 0; b < BPT; ++b)
#pragma unroll
        for (int r = 0; r < R; ++r) v[b][r] = buf[tid + NTHREADS * b + NBF * r];
    LDS_WAIT(); __syncthreads();
#pragma unroll
    for (int b = 0; b < BPT; ++b) {
        const int j = tid + NTHREADS * b, p = j >> LOGS, q = j & ((1 << LOGS) - 1);
        if (R == 8) dft8(v[b]); else dft16(v[b]);
        LAS cf* o = buf + q + ((p * R) << LOGS);
        o[0] = v[b][0];
        if (LOGN > 4) {
            const cf w1 = tw[p << (13 - LOGN)]; cf w = w1;
#pragma unroll
            for (int k = 1; k < R; ++k) { o[k << LOGS] = cmul(v[b][k], w); w = cmul(w, w1); }
        } else {
#pragma unroll
            for (int k = 1; k < R; ++k) o[k << LOGS] = v[b][k];
        }
    }
    LDS_WAIT(); __syncthreads();
}
__device__ __forceinline__ void fft8192(LAS cf* buf, const LAS cf* tw, int tid) {
    fft_pass<8, 0, 13>(buf, tw, tid); fft_pass<8, 3, 10>(buf, tw, tid); fft_pass<8, 6, 7>(buf, tw, tid); fft_pass<16, 9, 4>(buf, tw, tid);
}

__device__ __forceinline__ void ph_pre(Frame& F) {
    LAS float* sv = (LAS float*)F.lds; LAS float* red = sv + 5 * 1024;
    const float* c = F.in[1]; const float* c_ctx = F.in[3]; const float* ada_w = F.in[4]; const float* ada_b = F.in[5];
    float* mod = (float*)(F.ws + WS_MOD);
    for (int i = F.tid; i < 5 * 1024; i += NTHREADS) { const int r = i >> 10, k = i & 1023; const float x = r < 4 ? c[r * 1024 + k] : c_ctx[k]; sv[i] = x / (1.f + expf(-x)); }
    __syncthreads();
    for (int unit = F.bid; unit < 2 * 96; unit += F.G) {
        const int l = unit / 96, n0 = (unit % 96) * 64;
        const float* W = ada_w + (size_t)l * 1024 * NMOD + n0 + F.lane;
        float a0 = 0.f, a1 = 0.f, a2 = 0.f, a3 = 0.f, a4 = 0.f;
        const int k0 = F.wave * 128;
#pragma unroll 8
        for (int k = k0; k < k0 + 128; ++k) { const float w = W[(size_t)k * NMOD]; a0 += sv[k] * w; a1 += sv[1024 + k] * w; a2 += sv[2048 + k] * w; a3 += sv[3072 + k] * w; a4 += sv[4096 + k] * w; }
        red[(F.wave * 5 + 0) * 64 + F.lane] = a0; red[(F.wave * 5 + 1) * 64 + F.lane] = a1; red[(F.wave * 5 + 2) * 64 + F.lane] = a2; red[(F.wave * 5 + 3) * 64 + F.lane] = a3; red[(F.wave * 5 + 4) * 64 + F.lane] = a4;
        __syncthreads();
        if (F.tid < 320) { const int r = F.tid >> 6, ln = F.tid & 63; float s = 0.f;
#pragma unroll
            for (int w = 0; w < 8; ++w) s += red[(w * 5 + r) * 64 + ln];
            mod[((size_t)l * 5 + r) * NMOD + n0 + ln] = s + ada_b[l * NMOD + n0 + ln]; }
        __syncthreads();
    }
    float* pos = (float*)(F.ws + WS_POS);
    for (int i = F.bid * NTHREADS + F.tid; i < 64 * 512; i += F.G * NTHREADS) {
        const int p = i >> 9, d = i & 511, isc = d >> 8, k = d & 255;
        const float omega = 1.0f / powf(10000.0f, (float)k / 256.0f), a = (float)p * omega;
        pos[i] = isc ? cosf(a) : sinf(a);
    }
}

__device__ __forceinline__ void transpose_item(const float* W, int K, int N, bf16_t* WT, int glu, LAS float* scr, int item, int lane) {
    const int nblk = N / 32, kb = item / nblk, nb = item % nblk, k0 = 64 * kb, n0 = 32 * nb;
#pragma unroll 8
    for (int i = 0; i < 32; ++i) { const int kk = 2 * i + (lane >> 5); scr[kk * 33 + (lane & 31)] = W[(size_t)(k0 + kk) * N + n0 + (lane & 31)]; }
    LDS_WAIT(); asm volatile("" ::: "memory");
    const int n0p = glu ? (((n0 & 1023) >> 7) * 256 + (n0 >> 10) * 128 + (n0 & 127)) : n0;
    const int c = lane & 7;
#pragma unroll
    for (int j = 0; j < 4; ++j) { const int n = (lane >> 3) + 8 * j; const LAS float* s = scr + (8 * c) * 33 + n;
        u32x4 o; o.x = pk2(s[0 * 33], s[1 * 33]); o.y = pk2(s[2 * 33], s[3 * 33]); o.z = pk2(s[4 * 33], s[5 * 33]); o.w = pk2(s[6 * 33], s[7 * 33]);
        *(u32x4*)(WT + (size_t)(n0p + n) * K + k0 + 8 * c) = o; }
    LDS_WAIT(); asm volatile("" ::: "memory");
}
__device__ __forceinline__ void h3_row(const Frame& F, int l, int t, int L, float* H3, LAS float* scr) {
    const float* w1 = F.in[22] + l * 33 * 64; const float* b1 = F.in[23] + l * 64; const float* w2 = F.in[24] + l * 4096; const float* b2 = F.in[25] + l * 64;
    const float* w3 = F.in[26] + l * 4096; const float* b3 = F.in[27] + l * 64; const float* freq = F.in[28] + l * 64;
    const int j = F.lane;
    LAS float* z = scr; LAS float* h = scr + 64; LAS float* h2 = scr + 128;
    if (j == 0) z[0] = (float)t / (float)(L - 1);
    if (j < 16) { const float band = 1e-4f + (float)j * ((15.0f - 1e-4f) / 15.0f), ang = 6.283185307179586f * (float)t / (float)L; z[1 + j] = cosf(band * ang); z[17 + j] = -sinf(band * ang); }
    LDS_WAIT(); asm volatile("" ::: "memory");
    const float f = freq[j];
    float a = b1[j];
#pragma unroll 3
    for (int i = 0; i < 33; ++i) a += z[i] * w1[i * 64 + j];
    h[j] = sinf(f * a); LDS_WAIT(); asm volatile("" ::: "memory");
    a = b2[j];
#pragma unroll 8
    for (int i = 0; i < 64; ++i) a += h[i] * w2[i * 64 + j];
    h2[j] = sinf(f * a); LDS_WAIT(); asm volatile("" ::: "memory");
    a = b3[j];
#pragma unroll 8
    for (int i = 0; i < 64; ++i) a += h2[i] * w3[i * 64 + j];
    H3[(size_t)t * 64 + j] = sinf(f * a);
    LDS_WAIT(); asm volatile("" ::: "memory");
}
template <bool INIT> __device__ __forceinline__ void norm_row(const Frame& F, int row, const float* g, const float* modl, int shoff, bf16_t* Hout) {
    float* xs = xrow(F, row);
    f32x4 v[4];
    if (INIT) {
        if (row < ML) { const float* src = F.in[0] + (size_t)row * D; const float* pos = (const float*)(F.ws + WS_POS); const int t = row & 4095, pr = t >> 6, pc = t & 63;
#pragma unroll
            for (int j = 0; j < 4; ++j) { const int d = 4 * F.lane + 256 * j; const f32x4 e = *(const f32x4*)(pos + (size_t)(d < 512 ? pr : pc) * 512 + (d & 511)); v[j] = *(const f32x4*)(src + d) + e; *(f32x4*)(xs + d) = v[j]; } }
        else { const float* src = F.in[2] + (size_t)(row - ML) * D;
#pragma unroll
            for (int j = 0; j < 4; ++j) { const int d = 4 * F.lane + 256 * j; v[j] = *(const f32x4*)(src + d); *(f32x4*)(xs + d) = v[j]; } }
    } else {
#pragma unroll
        for (int j = 0; j < 4; ++j) v[j] = *(const f32x4*)(xs + 4 * F.lane + 256 * j);
    }
    float s = 0.f;
#pragma unroll
    for (int j = 0; j < 4; ++j) s += (v[j][0] * v[j][0] + v[j][1] * v[j][1]) + (v[j][2] * v[j][2] + v[j][3] * v[j][3]);
    const float rs = rsqrtf(wave_sum(s) * (1.f / D) + EPS);
    const float* mv = modl + (size_t)modrow(row) * NMOD + shoff;
#pragma unroll
    for (int j = 0; j < 4; ++j) { const int d = 4 * F.lane + 256 * j; const f32x4 gg = *(const f32x4*)(g + d), sh = *(const f32x4*)(mv + d), sc = *(const f32x4*)(mv + 1024 + d);
        const f32x4 y = (v[j] * rs) * gg * (sc + 1.f) + sh;
        u32x2 w; w.x = pk2(y[0], y[1]); w.y = pk2(y[2], y[3]); *(u32x2*)(Hout + (size_t)row * D + d) = w; }
}
__device__ __forceinline__ void s5_mats(const Frame& F, int l, int g) {
    LAS float* L = (LAS float*)F.lds;
    LAS float* pwr = L;
    LAS float* pwi = pwr + 2 * 33 * 64;
    LAS float* bbr = pwi + 2 * 33 * 64;
    LAS float* bbi = bbr + 2048;
    LAS float* ccr = bbi + 2048;
    LAS float* cci = ccr + 2048;
    LAS float* kt = cci + 2048;
    LAS float* dv = kt + 16384;
    const float* a_re = F.in[9] + l * 4096; const float* a_im = F.in[10] + l * 4096; const float* log_dt = F.in[11] + l * 64;
    const float* b_re = F.in[12] + (size_t)l * 65536; const float* b_im = F.in[13] + (size_t)l * 65536; const float* c_re = F.in[14] + (size_t)l * 65536; const float* c_im = F.in[15] + (size_t)l * 65536;
    const int tid = F.tid;
    if (tid < 128) {
        const int k = tid >> 6, n = tid & 63, kg = k * 32 + g;
        const float are = a_re[kg * 64 + n], aim = a_im[kg * 64 + n], dt = expf(log_dt[kg]);
        const float mag = expf(are * dt), ang = aim * dt, abr = mag * cosf(ang), abi = mag * sinf(ang);
        const float den = are * are + aim * aim, nr = abr - 1.f, ni = abi;
        const float fre = (nr * are + ni * aim) / den, fim = (ni * are - nr * aim) / den;
        for (int q = 0; q < 16; ++q) { const float br = b_re[((size_t)kg * 64 + n) * 16 + q], bi = b_im[((size_t)kg * 64 + n) * 16 + q];
            bbr[(k * 64 + n) * 16 + q] = fre * br - fim * bi; bbi[(k * 64 + n) * 16 + q] = fre * bi + fim * br; }
        float pr = 1.f, pi = 0.f;
        for (int e = 0; e <= 32; ++e) { pwr[(k * 33 + e) * 64 + n] = pr; pwi[(k * 33 + e) * 64 + n] = pi; const float t = pr * abr - pi * abi; pi = pr * abi + pi * abr; pr = t; }
        float* ap = (float*)(F.ws + WS_APOW) + ((size_t)(g * 2 + k) * 64 + n) * 2;
        ap[0] = pwr[(k * 33 + 32) * 64 + n]; ap[1] = pwi[(k * 33 + 32) * 64 + n];
    } else if (tid < 144) { dv[tid - 128] = F.in[16][l * 512 + g * 16 + (tid - 128)]; }
    for (int i = tid; i < 2048; i += NTHREADS) { const int k = i >> 10, p = (i >> 6) & 15, n = i & 63; const size_t o = ((size_t)(k * 32 + g) * 16 + p) * 64 + n; ccr[i] = c_re[o]; cci[i] = c_im[o]; }
    LDS_WAIT(); __syncthreads();
    for (int idx = tid; idx < 16384; idx += NTHREADS) {
        const int k = idx >> 13, tau = (idx >> 8) & 31, p = (idx >> 4) & 15, q = idx & 15;
        const LAS float* cr = ccr + (k * 16 + p) * 64; const LAS float* ci = cci + (k * 16 + p) * 64; const LAS float* pr = pwr + (k * 33 + tau) * 64; const LAS float* pi = pwi + (k * 33 + tau) * 64;
        const LAS float* br = bbr + k * 1024 + q; const LAS float* bi = bbi + k * 1024 + q;
        float s = 0.f;
#pragma unroll 4
        for (int n = 0; n < 64; ++n) { const float xr = cr[n] * pr[n] - ci[n] * pi[n], xi = cr[n] * pi[n] + ci[n] * pr[n]; s += xr * br[n * 16] - xi * bi[n * 16]; }
        kt[idx] = s;
    }
    LDS_WAIT(); __syncthreads();
    bf16_t* BTB = (bf16_t*)(F.ws + WS_BTB) + (size_t)g * 512 * UAK;
    for (int it = 0; it < 64; ++it) {
        const int row = it * 8 + (tid >> 6), c8 = tid & 63, j = row >> 4, p = row & 15, i = c8 >> 1, q0 = (c8 & 1) * 8;
        float v[8];
        if (i < j) { const LAS float* s = kt + ((0 * 32 + (j - i)) * 16 + p) * 16 + q0;
#pragma unroll
            for (int e = 0; e < 8; ++e) v[e] = s[e]; }
        else if (i > j) { const LAS float* s = kt + ((1 * 32 + (i - j)) * 16 + p) * 16 + q0;
#pragma unroll
            for (int e = 0; e < 8; ++e) v[e] = s[e]; }
        else { const LAS float* s0 = kt + (p * 16) + q0; const LAS float* s1 = kt + ((32 * 16 + p) * 16) + q0;
#pragma unroll
            for (int e = 0; e < 8; ++e) v[e] = s0[e] + s1[e] + ((q0 + e == p) ? dv[p] : 0.f); }
        u32x4 o; o.x = pk2(v[0], v[1]); o.y = pk2(v[2], v[3]); o.z = pk2(v[4], v[5]); o.w = pk2(v[6], v[7]);
        *(u32x4*)(BTB + (size_t)row * UAK + c8 * 8) = o;
    }
    for (int it = 0; it < 32; ++it) {
        const int id = it * NTHREADS + tid, row = id >> 5, ch = id & 31, j = row >> 4, p = row & 15, k = ch >> 4, n0 = (ch & 15) * 4, e = k ? (32 - j) : (j + 1);
        float v[8];
#pragma unroll
        for (int d = 0; d < 4; ++d) { const int n = n0 + d; const float cr = ccr[(k * 16 + p) * 64 + n], ci = cci[(k * 16 + p) * 64 + n], pr = pwr[(k * 33 + e) * 64 + n], pi = pwi[(k * 33 + e) * 64 + n];
            v[2 * d] = cr * pr - ci * pi; v[2 * d + 1] = -(cr * pi + ci * pr); }
        u32x4 o; o.x = pk2(v[0], v[1]); o.y = pk2(v[2], v[3]); o.z = pk2(v[4], v[5]); o.w = pk2(v[6], v[7]);
        *(u32x4*)(BTB + (size_t)row * UAK + 512 + ch * 8) = o;
    }
    bf16_t* WST = (bf16_t*)(F.ws + WS_WST) + (size_t)g * 256 * 512;
    for (int it = 0; it < 32; ++it) {
        const int id = it * NTHREADS + tid, s = id >> 6, c8 = id & 63, k = s >> 7, n = (s >> 1) & 63, ri = s & 1, i = c8 >> 1, q0 = (c8 & 1) * 8, e = k ? i : (31 - i);
        const float pr = pwr[(k * 33 + e) * 64 + n], pi = pwi[(k * 33 + e) * 64 + n];
        float v[8];
#pragma unroll
        for (int d = 0; d < 8; ++d) { const float br = bbr[(k * 64 + n) * 16 + q0 + d], bi = bbi[(k * 64 + n) * 16 + q0 + d]; v[d] = ri ? (pr * bi + pi * br) : (pr * br - pi * bi); }
        u32x4 o; o.x = pk2(v[0], v[1]); o.y = pk2(v[2], v[3]); o.z = pk2(v[4], v[5]); o.w = pk2(v[6], v[7]);
        *(u32x4*)(WST + (size_t)s * 512 + c8 * 8) = o;
    }
    LDS_WAIT(); __syncthreads();
}
template <int LAYER> __device__ __forceinline__ void ph_layer_prep(Frame& F) {
    constexpr int l = LAYER;
#ifndef NO_S5M
    if (F.bid < 32) s5_mats(F, l, F.bid);
#endif
    {
        LAS float* scr = (LAS float*)(F.lds + F.wave * 16384);
        constexpr int I_IN = 16 * 208, I_GLU = 8 * 64, I_SC = 8 * 32, I_HY = 8 * 32, I_OUT = 16 * 32, I_1 = 16 * 128, I_2 = 64 * 32;
        constexpr int NIT = I_IN + I_GLU + I_SC + I_HY + I_OUT + I_1 + I_2;
#ifndef NO_TR
        for (int it = F.gw; it < NIT; it += F.ngw) {
            int r = it;
            if (r < I_IN) { transpose_item(F.in[8] + (size_t)l * 1024 * 6656, 1024, 6656, (bf16_t*)(F.ws + WS_WIN), 0, scr, r, F.lane); continue; } r -= I_IN;
            if (r < I_GLU) { transpose_item(F.in[17] + (size_t)l * 512 * 2048, 512, 2048, (bf16_t*)(F.ws + WS_WGLU), 1, scr, r, F.lane); continue; } r -= I_GLU;
            if (r < I_SC) { transpose_item(F.in[19] + (size_t)l * 512 * 1024, 512, 1024, (bf16_t*)(F.ws + WS_WSC), 0, scr, r, F.lane); continue; } r -= I_SC;
            if (r < I_HY) { transpose_item(F.in[31] + (size_t)l * 512 * 1024, 512, 1024, (bf16_t*)(F.ws + WS_WHY), 0, scr, r, F.lane); continue; } r -= I_HY;
            if (r < I_OUT) { transpose_item(F.in[32] + (size_t)l * 1024 * 1024, 1024, 1024, (bf16_t*)(F.ws + WS_WOUT), 0, scr, r, F.lane); continue; } r -= I_OUT;
            if (r < I_1) { transpose_item(F.in[33] + (size_t)l * 1024 * 4096, 1024, 4096, (bf16_t*)(F.ws + WS_W1), 0, scr, r, F.lane); continue; } r -= I_1;
            transpose_item(F.in[34] + (size_t)l * 4096 * 1024, 4096, 1024, (bf16_t*)(F.ws + WS_W2), 0, scr, r, F.lane);
        }
#endif
        LAS float* hs = scr;
#ifndef NO_H3
        for (int t = F.gw; t < SEQ + (l == 0 ? CTXL : 0); t += F.ngw) {
            if (t < SEQ) h3_row(F, l, t, SEQ, (float*)(F.ws + WS_H3), hs); else h3_row(F, l, t - SEQ, CTXL, (float*)(F.ws + WS_H3C), hs);
        }
#endif
    }
    const float* modl = (const float*)(F.ws + WS_MOD) + (size_t)l * 5 * NMOD;
#ifndef NO_NORM
    for (int row = F.gw; row < MALL; row += F.ngw) norm_row<l == 0>(F, row, F.in[6] + l * D, modl, 0, (bf16_t*)(F.ws + WS_H));
#endif
}

__device__ __forceinline__ void ph_prep_sc(Frame& F, int l, int nrows) {
    const bf16_t* P = (const bf16_t*)(F.ws + WS_PBUF); bf16_t* O = (bf16_t*)(F.ws + WS_SCA); const float* w = F.in[18] + l * 1536;
    const int cg = F.tid & 63, rr = F.tid >> 6, c0 = cg * 8;
    float w0[8], w1[8], w2[8];
#pragma unroll
    for (int e = 0; e < 8; ++e) { w0[e] = w[c0 + e]; w1[e] = w[512 + c0 + e]; w2[e] = w[1024 + c0 + e]; }
    for (int blk = F.bid; blk < nrows / 64; blk += F.G) {
        const int r0 = blk * 64 + rr * 8;
        const int s0 = r0 < ML ? (r0 & ~4095) : (ML + ((r0 - ML) & ~255)), s1 = s0 + (r0 < ML ? SEQ : CTXL);
        float pa[8], pb[8], pc[8];
        auto prod = [&](int row, float* o) {
            if (row < s0 || row >= s1) {
#pragma unroll
                for (int e = 0; e < 8; ++e) o[e] = 0.f;
                return; }
            const u32x4 xv = *(const u32x4*)(P + (size_t)row * 1536 + c0), cv = *(const u32x4*)(P + (size_t)row * 1536 + 1024 + c0);
            f32x4 x0, x1, q0, q1; unpack8(xv, x0, x1); unpack8(cv, q0, q1);
#pragma unroll
            for (int e = 0; e < 4; ++e) { o[e] = x0[e] * q0[e]; o[4 + e] = x1[e] * q1[e]; }
        };
        prod(r0 - 1, pa); prod(r0, pb);
#pragma unroll 1
        for (int k = 0; k < 8; ++k) {
            const int row = r0 + k;
            prod(row + 1, pc);
            f32x4 b0, b1; unpack8(*(const u32x4*)(P + (size_t)row * 1536 + 512 + c0), b0, b1);
            float y[8];
#pragma unroll
            for (int e = 0; e < 8; ++e) y[e] = (e < 4 ? b0[e] : b1[e - 4]) * (w0[e] * pa[e] + w1[e] * pb[e] + w2[e] * pc[e]);
            u32x4 o; o.x = pk2(y[0], y[1]); o.y = pk2(y[2], y[3]); o.z = pk2(y[4], y[5]); o.w = pk2(y[6], y[7]);
            *(u32x4*)(O + (size_t)row * 512 + c0) = o;
#pragma unroll
            for (int e = 0; e < 8; ++e) { pa[e] = pb[e]; pb[e] = pc[e]; }
        }
    }
}
__device__ __forceinline__ void ph_prep_hy(Frame& F, int l, int ntiles) {
    const bf16_t* P = (const bf16_t*)(F.ws + WS_PBUF); bf16_t* X0 = (bf16_t*)(F.ws + WS_X0); bf16_t* UT = (bf16_t*)(F.ws + WS_UT); bf16_t* UTC = (bf16_t*)(F.ws + WS_UTC);
    const float* w = F.in[20] + l * 4608; const float* bias = F.in[21] + l * 1536;
    LAS bf16_t* ut = (LAS bf16_t*)F.lds;
    const int cg = F.tid & 7, rr = F.tid >> 3;
    for (int unit = F.bid; unit < ntiles * 8; unit += F.G) {
        const int pm = unit >> 3, cb = unit & 7, cbase = cb * 64 + cg * 8, rt = pm * 256, r0 = rt + rr * 4;
        const bool lo_ok = (pm < 64) && ((pm & 15) != 0), hi_ok = (pm < 64) && ((pm & 15) != 15);
        float qv[4][8];
#pragma unroll
        for (int pi = 0; pi < 3; ++pi) {
            const int part = pi == 0 ? 2 : pi - 1;
            const int col = part * 512 + cbase;
            float wa[8], wb[8], wc[8], bb[8];
#pragma unroll
            for (int e = 0; e < 8; ++e) { wa[e] = w[col + e]; wb[e] = w[1536 + col + e]; wc[e] = w[3072 + col + e]; bb[e] = bias[col + e]; }
            float rows[6][8];
#pragma unroll
            for (int k = 0; k < 6; ++k) { const int row = r0 - 1 + k; const bool ok = (row >= rt || lo_ok) && (row < rt + 256 || hi_ok);
                if (ok) { f32x4 a, b; unpack8(*(const u32x4*)(P + (size_t)row * 1536 + col), a, b);
#pragma unroll
                    for (int e = 0; e < 4; ++e) { rows[k][e] = a[e]; rows[k][4 + e] = b[e]; } }
                else {
#pragma unroll
                    for (int e = 0; e < 8; ++e) rows[k][e] = 0.f; } }
#pragma unroll
            for (int k = 0; k < 4; ++k) {
                float qk[8];
#pragma unroll
                for (int e = 0; e < 8; ++e) qk[e] = wa[e] * rows[k][e] + wb[e] * rows[k + 1][e] + wc[e] * rows[k + 2][e] + bb[e];
                if (part == 2) { u32x4 o; o.x = pk2(qk[0], qk[1]); o.y = pk2(qk[2], qk[3]); o.z = pk2(qk[4], qk[5]); o.w = pk2(qk[6], qk[7]); *(u32x4*)(X0 + (size_t)(r0 + k) * 512 + cbase) = o; }
                else if (part == 0) {
#pragma unroll
                    for (int e = 0; e < 8; ++e) qv[k][e] = qk[e]; }
                else {
#pragma unroll
                    for (int e = 0; e < 8; ++e) ut[(cg * 8 + e) * 264 + rr * 4 + k] = (bf16_t)f2bf(qk[e] * qv[k][e]); }
            }
        }
        LDS_WAIT(); __syncthreads();
#pragma unroll
        for (int it = 0; it < 4; ++it) { const int id = it * NTHREADS + F.tid, ch = id >> 5, pc = id & 31;
            const u32x4 v = *(const LAS u32x4*)(ut + ch * 264 + pc * 8);
            bf16_t* dst = pm < 64 ? UT + (size_t)(cb * 64 + ch) * ML + rt + pc * 8 : UTC + (size_t)(cb * 64 + ch) * MC + (rt - ML) + pc * 8;
            *(u32x4*)dst = v; }
        LDS_WAIT(); __syncthreads();
    }
}
__device__ __forceinline__ void s5_chain(Frame& F, int g) {
    const int n = F.tid & 63, k = (F.tid >> 6) & 1, b = F.tid >> 7;
    const float* ap = (const float*)(F.ws + WS_APOW) + ((size_t)(g * 2 + k) * 64 + n) * 2; const float ar = ap[0], ai = ap[1];
    const float* S = (const float*)(F.ws + WS_SLOC) + (size_t)g * UROWS * 256 + k * 128 + n * 2;
    bf16_t* U = (bf16_t*)(F.ws + WS_UA) + (size_t)g * UROWS * UAK + 512 + k * 128 + n * 2;
    float sr = 0.f, si = 0.f;
    constexpr int NST = NCHC + NCHL;
    auto rowof = [&](int st) -> int { if (st < NCHC) { const int cc = k ? (NCHC - 1 - st) : st; return NB * NCHL + b * NCHC + cc; } const int c = k ? (NCHL - 1 - (st - NCHC)) : (st - NCHC); return b * NCHL + c; };
#pragma unroll 1
    for (int st0 = 0; st0 < NST; st0 += 8) {
        f32x2 v[8]; int rws[8];
#pragma unroll
        for (int e = 0; e < 8; ++e) { rws[e] = rowof(st0 + e); v[e] = *(const f32x2*)(S + (size_t)rws[e] * 256); }
#pragma unroll
        for (int e = 0; e < 8; ++e) {
            *(unsigned*)(U + (size_t)rws[e] * UAK) = pk2(sr, si);
            const float t = ar * sr - ai * si + v[e].x; si = ar * si + ai * sr + v[e].y; sr = t;
        }
    }
}
__device__ __forceinline__ void ph_filter(Frame& F, int l, bool with_ctx) {
    LAS float* w4s = (LAS float*)F.lds;
    LAS float* red = w4s + 512;
    const float* w4 = F.in[29] + (size_t)l * 64 * 1024;
    const float MIND = -3.0701134573253944f, MAXD = -15.350567286626972f;
    const int nun = with_ctx ? 256 : 128;
    for (int unit = F.bid; unit < nun; unit += F.G) {
        const bool isc = unit >= 128; const int c0 = (unit & 127) * 4, Lh = isc ? CTXL : SEQ;
        const float* H3 = (const float*)(F.ws + (isc ? WS_H3C : WS_H3)); float* kT = (float*)(F.ws + (isc ? WS_KTC : WS_KT)); float* kinv = (float*)(F.ws + WS_KINV) + (isc ? 512 : 0);
        __syncthreads();
        { const int m = F.tid >> 3, e = F.tid & 7; w4s[F.tid] = w4[(size_t)m * 1024 + (e >> 2) * 512 + c0 + (e & 3)]; }
        LDS_WAIT(); __syncthreads();
        float dl[4]; float asum[4] = {0.f, 0.f, 0.f, 0.f};
#pragma unroll
        for (int ch = 0; ch < 4; ++ch) dl[ch] = fabsf(MIND + (float)(c0 + ch) * ((MAXD - MIND) / 511.0f));
        for (int t = F.tid; t < Lh; t += NTHREADS) {
            float acc[8] = {0.f, 0.f, 0.f, 0.f, 0.f, 0.f, 0.f, 0.f};
            const f32x4* hr = (const f32x4*)(H3 + (size_t)t * 64);
#pragma unroll 4
            for (int m4 = 0; m4 < 16; ++m4) { const f32x4 hv = hr[m4];
#pragma unroll
                for (int d = 0; d < 4; ++d)
#pragma unroll
                    for (int e = 0; e < 8; ++e) acc[e] += hv[d] * w4s[(m4 * 4 + d) * 8 + e]; }
            const float tt = (float)t / (float)(Lh - 1);
#pragma unroll
            for (int ch = 0; ch < 4; ++ch) {
                const float win = expf(-tt * dl[ch]) + 0.05f, vf = acc[ch] * win, vb = acc[4 + ch] * win;
                float* kr = kT + (size_t)(c0 + ch) * (2 * Lh);
                kr[t] = vf; asum[ch] += fabsf(vf);
                if (t >= 1) { kr[2 * Lh - t] = vb; asum[ch] += fabsf(vb); } else kr[Lh] = 0.f;
            }
        }
#pragma unroll
        for (int ch = 0; ch < 4; ++ch) { const float s = wave_sum(asum[ch]); if (F.lane == 0) red[F.wave * 8 + ch] = s; }
        LDS_WAIT(); __syncthreads();
        if (F.tid < 4) { float s = 0.f;
#pragma unroll
            for (int wv = 0; wv < 8; ++wv) s += red[wv * 8 + F.tid];
            kinv[c0 + F.tid] = 1.f / s; }
    }
    __syncthreads();
}
__device__ __forceinline__ void ph_fft(Frame& F, int l, bool with_ctx) {
    LAS cf* KH = (LAS cf*)F.lds; LAS cf* XB = KH + 8192; LAS cf* tw = XB + 8192;
    const int tid = F.tid;
    for (int i = tid; i < 1024; i += NTHREADS) { float s, c; sincospif(-(float)i * (1.0f / 4096.0f), &s, &c); tw[i] = (cf){c, s}; }
    LDS_WAIT(); __syncthreads();
    const float* kTa = (const float*)(F.ws + WS_KT); const float* kinv = (const float*)(F.ws + WS_KINV); const float* hd = F.in[30] + l * 512;
    bf16_t* UT = (bf16_t*)(F.ws + WS_UT);
    for (int c = F.bid; c < 512; c += F.G) {
        {
            const float sc = kinv[c]; const float* kr = kTa + (size_t)c * 8192 + tid * 16;
#pragma unroll
            for (int j = 0; j < 4; ++j) { const f32x4 v = *(const f32x4*)(kr + 4 * j);
#pragma unroll
                for (int e = 0; e < 4; ++e) KH[tid * 16 + 4 * j + e] = (cf){v[e] * sc, 0.f}; }
            LDS_WAIT(); __syncthreads();
            if (tid == 0) KH[0].x += hd[c];
            LDS_WAIT(); __syncthreads();
            fft8192(KH, tw, tid);
        }
#pragma unroll 1
        for (int pr = 0; pr < 2; ++pr) {
            bf16_t* u0 = UT + (size_t)c * ML + (size_t)(2 * pr) * SEQ + tid * 8; bf16_t* u1 = u0 + SEQ;
            { f32x4 a0, a1, b0, b1; unpack8(*(const u32x4*)u0, a0, a1); unpack8(*(const u32x4*)u1, b0, b1);
#pragma unroll
              for (int e = 0; e < 4; ++e) { XB[tid * 8 + e] = (cf){a0[e], b0[e]}; XB[tid * 8 + 4 + e] = (cf){a1[e], b1[e]}; }
#pragma unroll
              for (int e = 0; e < 8; ++e) XB[4096 + tid + NTHREADS * e] = (cf){0.f, 0.f}; }
            LDS_WAIT(); __syncthreads();
            fft8192(XB, tw, tid);
#pragma unroll
            for (int e = 0; e < 16; ++e) { const int i = tid + NTHREADS * e; const cf p = cmul(XB[i], KH[i]); XB[i] = (cf){p.x, -p.y}; }
            LDS_WAIT(); __syncthreads();
            fft8192(XB, tw, tid);
            { const float sn = 1.0f / 8192.0f; float zr[8], zi[8];
#pragma unroll
              for (int e = 0; e < 8; ++e) { const cf v = XB[tid * 8 + e]; zr[e] = v.x * sn; zi[e] = -v.y * sn; }
              u32x4 o; o.x = pk2(zr[0], zr[1]); o.y = pk2(zr[2], zr[3]); o.z = pk2(zr[4], zr[5]); o.w = pk2(zr[6], zr[7]); *(u32x4*)u0 = o;
              o.x = pk2(zi[0], zi[1]); o.y = pk2(zi[2], zi[3]); o.z = pk2(zi[4], zi[5]); o.w = pk2(zi[6], zi[7]); *(u32x4*)u1 = o; }
            LDS_WAIT(); __syncthreads();
        }
        if (with_ctx) {
            LAS float* kc = (LAS float*)XB; LAS float* uc = kc + 512;
            const float* kr = (const float*)(F.ws + WS_KTC) + (size_t)c * 512; const float sc = ((const float*)(F.ws + WS_KINV))[512 + c];
            bf16_t* ucg = (bf16_t*)(F.ws + WS_UTC) + (size_t)c * MC;
            kc[tid] = kr[tid] * sc + (tid == 0 ? hd[c] : 0.f);
            uc[tid] = bf1(ucg[tid]); uc[512 + tid] = bf1(ucg[512 + tid]);
            LDS_WAIT(); __syncthreads();
#pragma unroll 1
            for (int h = 0; h < 2; ++h) { const int o = tid + NTHREADS * h, b = o >> 8, t = o & 255; float s = 0.f;
#pragma unroll 8
                for (int s_ = 0; s_ < 256; ++s_) s += kc[(t - s_) & 511] * uc[b * 256 + s_];
                ucg[o] = (bf16_t)f2bf(s); }
            LDS_WAIT(); __syncthreads();
        }
    }
}
__device__ __forceinline__ void ph_post(Frame& F, int ntiles) {
    bf16_t* X0 = (bf16_t*)(F.ws + WS_X0); const bf16_t* UT = (const bf16_t*)(F.ws + WS_UT); const bf16_t* UTC = (const bf16_t*)(F.ws + WS_UTC);
    LAS bf16_t* zt = (LAS bf16_t*)F.lds;
    const int cg = F.tid & 7, rr = F.tid >> 3;
    for (int unit = F.bid; unit < ntiles * 8; unit += F.G) {
        const int pm = unit >> 3, cb = unit & 7, rt = pm * 256;
#pragma unroll
        for (int it = 0; it < 4; ++it) { const int id = it * NTHREADS + F.tid, ch = id >> 5, pc = id & 31;
            const bf16_t* src = pm < 64 ? UT + (size_t)(cb * 64 + ch) * ML + rt + pc * 8 : UTC + (size_t)(cb * 64 + ch) * MC + (rt - ML) + pc * 8;
            *(LAS u32x4*)(zt + ch * 264 + pc * 8) = *(const u32x4*)src; }
        LDS_WAIT(); __syncthreads();
#pragma unroll
        for (int k = 0; k < 4; ++k) { const int rl = rr * 4 + k; bf16_t* xp = X0 + (size_t)(rt + rl) * 512 + cb * 64 + cg * 8;
            f32x4 a, b; unpack8(*(const u32x4*)xp, a, b); float y[8];
#pragma unroll
            for (int e = 0; e < 8; ++e) y[e] = (e < 4 ? a[e] : b[e - 4]) * bf1(zt[(cg * 8 + e) * 264 + rl]);
            u32x4 o; o.x = pk2(y[0], y[1]); o.y = pk2(y[2], y[3]); o.z = pk2(y[4], y[5]); o.w = pk2(y[6], y[7]); *(u32x4*)xp = o; }
        LDS_WAIT(); __syncthreads();
    }
}
__device__ __forceinline__ void ph_final(Frame& F) {
    const float* g = F.in[35];
    for (int row = F.gw; row < ML; row += F.ngw) { float* xs = F.out + (size_t)row * D; f32x4 v[4]; float s = 0.f;
#pragma unroll
        for (int j = 0; j < 4; ++j) { v[j] = *(const f32x4*)(xs + 4 * F.lane + 256 * j); s += (v[j][0] * v[j][0] + v[j][1] * v[j][1]) + (v[j][2] * v[j][2] + v[j][3] * v[j][3]); }
        const float rs = rsqrtf(wave_sum(s) * (1.f / D) + EPS);
#pragma unroll
        for (int j = 0; j < 4; ++j) { const int d = 4 * F.lane + 256 * j; *(f32x4*)(xs + d) = (v[j] * rs) * *(const f32x4*)(g + d); } }
}
constexpr int NPH = 1 + 2 * 12 + 1;

__device__ __forceinline__ bool fresh(Frame& F) { asm volatile("" : "+v"(F.tid), "+v"(F.lane)); return true; }
template <int LAYER> __device__ __forceinline__ void layer_phases(Frame& F, const XcdBarrier& bar, int lo, int hi) {
    constexpr int l = LAYER, P0 = 1 + 12 * LAYER;
    constexpr bool last = (LAYER == 1);
    constexpr int nMa = last ? 64 : 68;
    unsigned char* ws = F.ws; const int c = F.bid, G = F.G;
    const float* modl = (const float*)(ws + WS_MOD) + (size_t)l * 5 * NMOD;
#define IN_PH(k) (lo <= P0 + (k) && P0 + (k) < hi && fresh(F))
#define SEAM(k) do { if (MK_PER_PHASE == 0 && (lo <= P0 + (k) && P0 + (k) < hi) && (P0 + (k) + 1) < hi) xcd_barrier(bar); } while (0)
#define LOCAL_SYNC() do { VM_WAIT(); __syncthreads(); } while (0)
    if (IN_PH(0)) { ph_layer_prep<LAYER>(F); } SEAM(0);
    if (IN_PH(1)) {
        pg8::GridOrder S; S.init(1, nMa, 8, G, c, ws + WS_H, (size_t)256 * 1024 * 2, 0, ws + WS_WIN, (size_t)256 * 1024 * 2, 0);
        if (last) S.extra(4, 2, 64);
        EpiWinA E{(bf16_t*)(ws + WS_UA), (bf16_t*)(ws + WS_PBUF)};
        pg8::gemm_phase(F.lds, pg8::GemmP{1024, 1024, 1024}, S, E);
    } SEAM(1);
    if (IN_PH(2)) {
        pg8::GridOrder S; S.init(32, 3, 1, G, c, ws + WS_UA, (size_t)256 * UAK * 2, (size_t)UROWS * UAK * 2, ws + WS_WST, (size_t)256 * 512 * 2, (size_t)256 * 512 * 2);
        EpiSloc E{(float*)(ws + WS_SLOC)};
        pg8::gemm_phase(F.lds, pg8::GemmP{UAK, 512, 512}, S, E);
        ph_prep_sc(F, l, nMa * 256);
    } SEAM(2);
    if (IN_PH(3)) {
        pg8::GridOrder S; S.init(1, nMa, 6, G, c, ws + WS_H, (size_t)256 * 1024 * 2, 0, ws + WS_WIN + (size_t)2048 * 1024 * 2, (size_t)256 * 1024 * 2, 0);
        EpiBf16 E{(bf16_t*)(ws + WS_PBUF), 1536};
        pg8::gemm_phase(F.lds, pg8::GemmP{1024, 1024, 1024}, S, E);
        for (int g = G - 1 - c; g < 32; g += G) s5_chain(F, g);
    } SEAM(3);
    if (IN_PH(4)) { ph_prep_hy(F, l, nMa); LOCAL_SYNC(); ph_filter(F, l, !last); } SEAM(4);
    if (IN_PH(5)) {
        pg8::GridOrder S; S.init(32, 3, 2, G, c, ws + WS_UA, (size_t)256 * UAK * 2, (size_t)UROWS * UAK * 2, ws + WS_BTB, (size_t)256 * UAK * 2, (size_t)512 * UAK * 2);
        EpiYpre E{(bf16_t*)(ws + WS_YPRE)};
        pg8::gemm_phase(F.lds, pg8::GemmP{UAK, UAK, UAK}, S, E);
        ph_fft(F, l, !last);
    } SEAM(5);
    if (IN_PH(6)) { ph_post(F, nMa); } SEAM(6);
    if (IN_PH(7)) {
        pg8::GridOrder SG; SG.init(1, nMa, 4, G, c, ws + WS_H, (size_t)256 * 1024 * 2, 0, ws + WS_WIN + (size_t)3584 * 1024 * 2, (size_t)256 * 1024 * 2, 0);
        EpiGate EG{(bf16_t*)(ws + WS_GATE)};
        pg8::gemm_phase(F.lds, pg8::GemmP{1024, 1024, 1024}, SG, EG); LOCAL_SYNC();
        { pg8::GluOrder S; S.base.init(1, nMa, 4, G, c, ws + WS_YPRE, (size_t)256 * 512 * 2, 0, ws + WS_WGLU, 0, 0); S.B = (const char*)(ws + WS_WGLU); S.tB = (size_t)256 * 512 * 2;
          EpiBranch<0> E{(bf16_t*)(ws + WS_M), (const bf16_t*)(ws + WS_GATE)};
          pg8::gemm_phase(F.lds, pg8::GemmP{512, 512, 512}, S, E); LOCAL_SYNC(); }
        SG.B = (const char*)(ws + WS_WIN + (size_t)(3584 + 1024) * 1024 * 2);
        pg8::gemm_phase(F.lds, pg8::GemmP{1024, 1024, 1024}, SG, EG); LOCAL_SYNC();
        { pg8::GridOrder S; S.init(1, nMa, 4, G, c, ws + WS_SCA, (size_t)256 * 512 * 2, 0, ws + WS_WSC, (size_t)256 * 512 * 2, 0);
          EpiBranch<1> E{(bf16_t*)(ws + WS_M), (const bf16_t*)(ws + WS_GATE)};
          pg8::gemm_phase(F.lds, pg8::GemmP{512, 512, 512}, S, E); LOCAL_SYNC(); }
        SG.B = (const char*)(ws + WS_WIN + (size_t)(3584 + 2048) * 1024 * 2);
        pg8::gemm_phase(F.lds, pg8::GemmP{1024, 1024, 1024}, SG, EG); LOCAL_SYNC();
        { pg8::GridOrder S; S.init(1, nMa, 4, G, c, ws + WS_X0, (size_t)256 * 512 * 2, 0, ws + WS_WHY, (size_t)256 * 512 * 2, 0);
          EpiBranch<1> E{(bf16_t*)(ws + WS_M), (const bf16_t*)(ws + WS_GATE)};
          pg8::gemm_phase(F.lds, pg8::GemmP{512, 512, 512}, S, E); }
    } SEAM(7);
    if (IN_PH(8)) {
        pg8::GridOrder S; S.init(1, nMa, 4, G, c, ws + WS_M, (size_t)256 * 1024 * 2, 0, ws + WS_WOUT, (size_t)256 * 1024 * 2, 0);
        EpiResid E{F.out, (float*)(ws + WS_XC), modl + 2048};
        pg8::gemm_phase(F.lds, pg8::GemmP{1024, 1024, 1024}, S, E);
    } SEAM(8);
    if (IN_PH(9)) { for (int row = F.gw; row < nMa * 256; row += F.ngw) norm_row<false>(F, row, F.in[7] + l * D, modl, 3072, (bf16_t*)(ws + WS_H)); } SEAM(9);
    if (IN_PH(10)) {
        pg8::GridOrder S; S.init(1, nMa, 16, G, c, ws + WS_H, (size_t)256 * 1024 * 2, 0, ws + WS_W1, (size_t)256 * 1024 * 2, 0);
        EpiRelu2 E{(bf16_t*)(ws + WS_R)};
        pg8::gemm_phase(F.lds, pg8::GemmP{1024, 1024, 1024}, S, E);
    } SEAM(10);
    if (IN_PH(11)) {
        pg8::GridOrder S; S.init(1, nMa, 4, G, c, ws + WS_R, (size_t)256 * 4096 * 2, 0, ws + WS_W2, (size_t)256 * 4096 * 2, 0);
        EpiResid E{F.out, (float*)(ws + WS_XC), modl + 5120};
        pg8::gemm_phase(F.lds, pg8::GemmP{4096, 4096, 4096}, S, E);
    } SEAM(11);
#undef IN_PH
#undef SEAM
}

__global__ void __launch_bounds__(NTHREADS, 2) mk_fwd(Args args) {
    extern __shared__ __attribute__((aligned(16))) unsigned char lds_raw[];
    Frame F;
    F.lds = (LAS unsigned char*)lds_raw;
    F.tid = threadIdx.x; F.lane = F.tid & 63; F.wave = __builtin_amdgcn_readfirstlane(F.tid >> 6);
    F.G = gridDim.x; F.bid = blockIdx.x; F.gw = F.bid * NWAVES + F.wave; F.ngw = F.G * NWAVES;
    F.in = (const float* const __attribute__((address_space(4)))*)__builtin_amdgcn_kernarg_segment_ptr();
    F.out = args.out; F.ws = args.ws;
    volatile LAS unsigned* MISC = (volatile LAS unsigned*)(F.lds + MISC_OFF);
    for (int u = F.tid; u < (LDS_BYTES - LDSCTL_OFF) / 4; u += NTHREADS) ((LAS unsigned*)(F.lds + LDSCTL_OFF))[u] = 0u;
    __syncthreads();
    XcdBarrier bar; bar.bar = (unsigned*)(F.ws + WS_CTL) + CW_BAR; bar.x = 0; bar.st = nullptr;
    if (MK_PER_PHASE == 0) bar = xcd_barrier_post((unsigned*)(F.ws + WS_CTL) + CW_BAR, MISC + 8);
#ifdef DBG_LO
    const int lo = DBG_LO, hi = DBG_HI;
#else
    const int lo = args.ph_lo, hi = args.ph_hi;
#endif
    if (lo <= 0 && 0 < hi) { ph_pre(F); if (MK_PER_PHASE == 0 && 1 < hi) xcd_barrier(bar); }
    layer_phases<0>(F, bar, lo, hi);
    layer_phases<1>(F, bar, lo, hi);
    if (lo <= NPH - 1 && NPH - 1 < hi) ph_final(F);
}
}

extern "C" void kernel_launch(void* const* d_in, const int* in_sizes, int n_in, void* d_out, int out_size, void* d_ws, size_t ws_size, hipStream_t stream) {
    using namespace mk;
    static int grid = 0;
    if (grid == 0) {
        if (n_in != 36 || out_size != ML * D || ws_size < WS_END) { fprintf(stderr, "kernel_launch: unexpected shapes (n_in %d out %d ws %zu need %zu)\n", n_in, out_size, ws_size, (size_t)WS_END); grid = -1; return; }
        int dev = 0, cus = 0, per_cu = 0;
        if (hipGetDevice(&dev) != hipSuccess || hipDeviceGetAttribute(&cus, hipDeviceAttributeMultiprocessorCount, dev) != hipSuccess) { grid = -1; return; }
        if (hipFuncSetAttribute((const void*)mk_fwd, hipFuncAttributeMaxDynamicSharedMemorySize, LDS_BYTES) != hipSuccess) { fprintf(stderr, "kernel_launch: hipFuncSetAttribute failed\n"); grid = -1; return; }
        if (hipOccupancyMaxActiveBlocksPerMultiprocessor(&per_cu, (const void*)mk_fwd, NTHREADS, LDS_BYTES) != hipSuccess || per_cu < 1) { fprintf(stderr, "kernel_launch: occupancy query says %d\n", per_cu); (void)hipGetLastError(); grid = -1; return; }
        grid = cus;
    }
    if (grid < 0) return;
    (void)hipMemsetAsync((char*)d_ws + WS_CTL, 0, CTL_BYTES, stream);
    Args a{};
    for (int i = 0; i < 36; ++i) a.in[i] = (const float*)d_in[i];
    a.out = (float*)d_out; a.ws = (unsigned char*)d_ws;
#if MK_PER_PHASE
    for (int ph = 0; ph < NPH; ++ph) { a.ph_lo = ph; a.ph_hi = ph + 1; hipLaunchKernelGGL(mk_fwd, dim3(grid), dim3(NTHREADS), LDS_BYTES, stream, a); }
#else
    a.ph_lo = 0; a.ph_hi = NPH;
    hipLaunchKernelGGL(mk_fwd, dim3(grid), dim3(NTHREADS), LDS_BYTES, stream, a);
#endif
}
```

```cpp
#include <hip/hip_runtime.h>
#include <cstdio>
#include <cstdint>

#ifndef MK_PER_PHASE
#define MK_PER_PHASE 0
#endif

#define LAS __attribute__((address_space(3)))
#define GAS __attribute__((address_space(1)))
typedef unsigned short bf16_t;
typedef short bf16x8 __attribute__((ext_vector_type(8)));
typedef float f32x4 __attribute__((ext_vector_type(4)));
typedef float f32x2 __attribute__((ext_vector_type(2)));
typedef unsigned u32x4 __attribute__((ext_vector_type(4)));
typedef unsigned u32x2 __attribute__((ext_vector_type(2)));
typedef GAS unsigned gu32;

namespace pg8 {
constexpr int BM = 256, BK = 64, HALF = 128, HTB = HALF * BK * 2, STAGE_BYTES = 8 * HTB, NXCD = 8, WGM = 8;
__host__ __device__ __forceinline__ int lds_byte(int r, int c) { const int st = (r >> 4) * 2 + (c >> 5), rr = r & 15, cc = c & 31, ob = rr * 64 + cc * 2; return st * 1024 + (ob ^ (((ob >> 9) & 1) << 5)); }
__host__ __device__ __forceinline__ void stage_rc(int b, int& R, int& C) { const int st = b / 1024, sb = b % 1024, swz = sb ^ (((sb >> 9) & 1) << 5); R = (st >> 1) * 16 + swz / 64; C = (st & 1) * 32 + (swz % 64) / 2; }
__host__ __device__ __forceinline__ int perm32(int rho) { const int n = rho >> 4, i = rho & 15; return 8 * (i >> 2) + 4 * n + (i & 3); }

struct Unit { int pm, pn, g; const char* A; const char* B; };
struct GemmP { int lda, ldb, K; };

struct GridOrder {
    int nM, nN, nG, nEM, nEN, nmain, nwg, G, c;
    int pm0, pn0, epm0;
    const char* A; const char* B; size_t tA, tB, gA, gB;
    __device__ __forceinline__ void init(int nG_, int nM_, int nN_, int G_, int c_, const void* A_, size_t tA_, size_t gA_, const void* B_, size_t tB_, size_t gB_) {
        nG = nG_; nM = nM_; nN = nN_; nEM = 0; nEN = 0; nmain = nG * nM * nN; nwg = nmain; G = G_; c = c_; pm0 = 0; pn0 = 0; epm0 = 0;
        A = (const char*)A_; B = (const char*)B_; tA = tA_; tB = tB_; gA = gA_; gB = gB_;
    }
    __device__ __forceinline__ void extra(int nEM_, int nEN_, int epm0_) { nEM = nEM_; nEN = nEN_; epm0 = epm0_; nwg = nmain + nEM * nEN; }
    __device__ __forceinline__ bool next(int i, Unit& u) const {
        const long L = (long)i * G + c; if (L >= nwg) return false;
        int pm, pn, g = 0;
        if (L >= nmain) { const int e = (int)L - nmain; pm = epm0 + e / nEN; pn = pn0 + e % nEN; }
        else {
            int wgid = (int)L; { const int q = nmain / NXCD, r = nmain % NXCD, xcd = wgid % NXCD, off = wgid / NXCD; wgid = (xcd < r ? xcd * (q + 1) : r * (q + 1) + (xcd - r) * q) + off; }
            const int per = nM * nN; g = wgid / per; const int w = wgid % per;
            const int nig = WGM * nN, gid = w / nig, fm = gid * WGM, gsz = (nM - fm) < WGM ? (nM - fm) : WGM;
            pm = pm0 + fm + ((w % nig) % gsz); pn = pn0 + (w % nig) / gsz;
        }
        u.pm = pm; u.pn = pn; u.g = g; u.A = A + (size_t)g * gA + (size_t)pm * tA; u.B = B + (size_t)g * gB + (size_t)pn * tB; return true;
    }
};
struct GluOrder {
    GridOrder base; const char* B; size_t tB;
    __device__ __forceinline__ bool next(int i, Unit& u) const {
        Unit b; if (!base.next(i >> 1, b)) return false;
        u.pm = b.pm; u.pn = 2 * b.pn + (i & 1); u.g = 0; u.A = b.A; u.B = B + (size_t)u.pn * tB; return true;
    }
};

__device__ __forceinline__ unsigned cvt_pk_bf16(float lo, float hi) { unsigned r; asm volatile("v_cvt_pk_bf16_f32 %0, %1, %2" : "=v"(r) : "v"(lo), "v"(hi)); return r; }

template <class Epi, class Sched>
__device__ __forceinline__ void gemm_phase(LAS unsigned char* lds, const GemmP g, const Sched& S, const Epi& E) {
    int tid_ = threadIdx.x; asm volatile("" : "+v"(tid_));
    const int tid = tid_, wid = __builtin_amdgcn_readfirstlane(tid >> 6), lane = tid & 63, wr = wid >> 2, wc = wid & 3, fr = lane & 15, fq = lane >> 4;
    const int nt = g.K / BK;
    unsigned voffA[2], voffB[2];
#pragma unroll
    for (int i = 0; i < 2; ++i) { int R, C; stage_rc(tid * 16 + i * 8192, R, C); const int Rb = Epi::PERM ? ((R & ~31) + perm32(R & 31)) : R;
        voffA[i] = (unsigned)(R * g.lda + C) * 2u; voffB[i] = (unsigned)(Rb * g.ldb + C) * 2u; }
    const size_t kstep = (size_t)(BK * 2);
    const size_t hstepA = (size_t)HALF * g.lda * 2, hstepB = (size_t)HALF * g.ldb * 2;
    const unsigned ldsw = (unsigned)wid * 1024u;
    const int aoff = lds_byte(wr * 64 + fr, fq * 8), boff = lds_byte(wc * 32 + fr, fq * 8);
#define PG8_SA(b, h) (((b) * 2 + (h)) * HTB)
#define PG8_SB(b, h) ((4 + (b) * 2 + (h)) * HTB)
#define PG8_STAGE(bufoff, gbase, voff) do { _Pragma("unroll") for (int _i = 0; _i < 2; ++_i) \
        __builtin_amdgcn_global_load_lds((const unsigned*)((const char*)(gbase) + (voff)[_i]), (LAS unsigned*)(lds + (bufoff) + ldsw + _i * 8192), 16, 0, 0); } while (0)
#define PG8_LDA(dst, b, h) do { _Pragma("unroll") for (int m = 0; m < 4; ++m) _Pragma("unroll") for (int k = 0; k < 2; ++k) dst[m][k] = *(const LAS bf16x8*)(lds + PG8_SA(b, h) + aoff + m * 2048 + k * 1024); } while (0)
#define PG8_LDB(dst, b, h) do { _Pragma("unroll") for (int n = 0; n < 2; ++n) _Pragma("unroll") for (int k = 0; k < 2; ++k) dst[n][k] = *(const LAS bf16x8*)(lds + PG8_SB(b, h) + boff + n * 2048 + k * 1024); } while (0)
#define PG8_MMA(ai, bj, At, Bt) do { __builtin_amdgcn_s_setprio(1); _Pragma("unroll") for (int m = 0; m < 4; ++m) _Pragma("unroll") for (int n = 0; n < 2; ++n) _Pragma("unroll") for (int k = 0; k < 2; ++k) \
        acc[ai][bj][m][n] = __builtin_amdgcn_mfma_f32_16x16x32_bf16(Bt[n][k], At[m][k], acc[ai][bj][m][n], 0, 0, 0); __builtin_amdgcn_s_setprio(0); } while (0)
#define PG8_WAIT_V(n) asm volatile("s_waitcnt vmcnt(" #n ")" ::: "memory")
#define PG8_WAIT_L(n) asm volatile("s_waitcnt lgkmcnt(" #n ")" ::: "memory")
#define PG8_BAR __builtin_amdgcn_s_barrier()
#define PG8_SCHED __builtin_amdgcn_sched_barrier(0)
    Unit cur, nxt; int ui = 0;
    if (!S.next(0, cur)) return;
    f32x4 acc[2][2][4][2];
#pragma unroll
    for (int a = 0; a < 2; ++a)
#pragma unroll
        for (int b = 0; b < 2; ++b)
#pragma unroll
            for (int m = 0; m < 4; ++m)
#pragma unroll
                for (int n = 0; n < 2; ++n) acc[a][b][m][n] = (f32x4){0.f, 0.f, 0.f, 0.f};
    bf16x8 At[4][2], B0[2][2], B1[2][2];
    const char* cA = cur.A; const char* cB = cur.B;
    PG8_STAGE(PG8_SB(0, 0), cB, voffB); PG8_STAGE(PG8_SB(0, 1), cB + hstepB, voffB); PG8_STAGE(PG8_SA(0, 0), cA, voffA); PG8_STAGE(PG8_SA(0, 1), cA + hstepA, voffA);
    if (wr == 1) PG8_BAR;
    PG8_WAIT_V(2); PG8_BAR;
    PG8_STAGE(PG8_SB(1, 0), cB + kstep, voffB); PG8_STAGE(PG8_SA(1, 0), cA + kstep, voffA); PG8_STAGE(PG8_SB(1, 1), cB + hstepB + kstep, voffB);
    PG8_WAIT_V(6); PG8_BAR;
    for (;;) {
        const bool has_next = S.next(ui + 1, nxt);
        const char* nA = has_next ? nxt.A : cA; const char* nB = has_next ? nxt.B : cB;
        for (int t = 0; t < nt; t += 2) {
            const bool last = (t == nt - 2);
            const char* a1 = cA + (size_t)(t + 1) * kstep;
            const char* a2 = last ? nA : cA + (size_t)(t + 2) * kstep; const char* b2 = last ? nB : cB + (size_t)(t + 2) * kstep;
            const char* a3 = a2 + kstep; const char* b3 = b2 + kstep;
            PG8_LDB(B0, 0, 0); PG8_LDB(B1, 0, 1); PG8_SCHED; PG8_LDA(At, 0, 0); PG8_STAGE(PG8_SA(1, 1), a1 + hstepA, voffA);
            PG8_WAIT_V(8); PG8_WAIT_L(0); PG8_BAR; PG8_MMA(0, 0, At, B0); PG8_MMA(0, 1, At, B1); PG8_BAR; PG8_SCHED;
            PG8_LDA(At, 0, 1); PG8_STAGE(PG8_SB(0, 0), b2, voffB); PG8_STAGE(PG8_SB(0, 1), b2 + hstepB, voffB); PG8_STAGE(PG8_SA(0, 0), a2, voffA);
            PG8_WAIT_V(8); PG8_WAIT_L(0); PG8_BAR; PG8_MMA(1, 0, At, B0); PG8_MMA(1, 1, At, B1); PG8_BAR; PG8_SCHED;
            PG8_LDB(B0, 1, 0); PG8_LDB(B1, 1, 1); PG8_SCHED; PG8_LDA(At, 1, 0); PG8_STAGE(PG8_SA(0, 1), a2 + hstepA, voffA);
            PG8_WAIT_V(8); PG8_WAIT_L(0); PG8_BAR; PG8_MMA(0, 0, At, B0); PG8_MMA(0, 1, At, B1); PG8_BAR; PG8_SCHED;
            PG8_LDA(At, 1, 1); PG8_STAGE(PG8_SB(1, 0), b3, voffB); PG8_STAGE(PG8_SB(1, 1), b3 + hstepB, voffB); PG8_STAGE(PG8_SA(1, 0), a3, voffA);
            PG8_WAIT_V(8); PG8_WAIT_L(0); PG8_BAR; PG8_MMA(1, 0, At, B0); PG8_MMA(1, 1, At, B1); PG8_BAR; PG8_SCHED;
        }
        if (wr == 0) PG8_BAR;
        E(acc, cur, wr, wc, fr, fq);
        if (!has_next) break;
#pragma unroll
        for (int a = 0; a < 2; ++a)
#pragma unroll
            for (int b = 0; b < 2; ++b)
#pragma unroll
                for (int m = 0; m < 4; ++m)
#pragma unroll
                    for (int n = 0; n < 2; ++n) acc[a][b][m][n] = (f32x4){0.f, 0.f, 0.f, 0.f};
        cur = nxt; cA = nA; cB = nB; ++ui;
        if (wr == 1) PG8_BAR;
    }
    PG8_WAIT_V(0);
    PG8_BAR;
#undef PG8_SA
#undef PG8_SB
#undef PG8_STAGE
#undef PG8_LDA
#undef PG8_LDB
#undef PG8_MMA
#undef PG8_WAIT_V
#undef PG8_WAIT_L
#undef PG8_BAR
#undef PG8_SCHED
}
}
namespace mk {
constexpr int NWAVES = 8, NTHREADS = 512;
constexpr int D = 1024, NB = 4, SEQ = 4096, CTXL = 256, DFF = 4096, NMOD = 6144;
constexpr int ML = NB * SEQ, MC = NB * CTXL, MALL = ML + MC;
constexpr int TCH = 32, NCHL = SEQ / TCH, NCHC = CTXL / TCH, UROWS = NB * NCHL + NB * NCHC;
constexpr int UAK = 768;
constexpr float EPS = 1e-6f;

constexpr size_t al(size_t x) { return (x + 255) & ~(size_t)255; }
constexpr size_t WS_CTL = 0, CTL_BYTES = 1u << 20;
constexpr size_t WS_MOD = WS_CTL + CTL_BYTES;
constexpr size_t WS_POS = al(WS_MOD + (size_t)2 * 5 * NMOD * 4);
constexpr size_t WS_H3 = al(WS_POS + 64 * 512 * 4);
constexpr size_t WS_H3C = al(WS_H3 + (size_t)SEQ * 64 * 4);
constexpr size_t WS_KINV = al(WS_H3C + (size_t)CTXL * 64 * 4);
constexpr size_t WS_APOW = al(WS_KINV + 1024 * 4);
constexpr size_t WS_WIN = al(WS_APOW + 32 * 2 * 64 * 2 * 4);
constexpr size_t WS_WGLU = al(WS_WIN + (size_t)6656 * 1024 * 2);
constexpr size_t WS_WSC = al(WS_WGLU + (size_t)2048 * 512 * 2);
constexpr size_t WS_WHY = al(WS_WSC + (size_t)1024 * 512 * 2);
constexpr size_t WS_WOUT = al(WS_WHY + (size_t)1024 * 512 * 2);
constexpr size_t WS_W1 = al(WS_WOUT + (size_t)1024 * 1024 * 2);
constexpr size_t WS_W2 = al(WS_W1 + (size_t)4096 * 1024 * 2);
constexpr size_t WS_BTB = al(WS_W2 + (size_t)1024 * 4096 * 2);
constexpr size_t WS_WST = al(WS_BTB + (size_t)32 * 512 * 768 * 2);
constexpr size_t WS_H = al(WS_WST + (size_t)32 * 256 * 512 * 2);
constexpr size_t WS_XC = al(WS_H + (size_t)MALL * 1024 * 2);
constexpr size_t WS_SEC = al(WS_XC + (size_t)MC * 1024 * 4);
constexpr size_t WS_PBUF = WS_SEC;
constexpr size_t WS_YPRE = WS_PBUF;
constexpr size_t WS_GATE = al(WS_PBUF + (size_t)MALL * 512 * 2);
constexpr size_t WS_UA = al(WS_PBUF + (size_t)MALL * 1536 * 2);
constexpr size_t WS_SLOC = al(WS_UA + (size_t)(32 * UROWS + 256) * UAK * 2);
constexpr size_t WS_KT = WS_SLOC;
constexpr size_t WS_M = WS_UA;
constexpr size_t WS_SCA = al(WS_SLOC + (size_t)32 * UROWS * 256 * 4);
constexpr size_t WS_X0 = al(WS_SCA + (size_t)MALL * 512 * 2);
constexpr size_t WS_UT = al(WS_X0 + (size_t)MALL * 512 * 2);
constexpr size_t WS_UTC = al(WS_UT + (size_t)512 * ML * 2);
constexpr size_t WS_KTC = al(WS_UTC + (size_t)512 * MC * 2);
constexpr size_t WS_SEC_END = al(WS_KTC + (size_t)512 * 512 * 4);
constexpr size_t WS_R = WS_SEC;
constexpr size_t WS_END = WS_SEC_END;
static_assert(WS_M + (size_t)MALL * 1024 * 2 <= WS_SCA, "m overlays UA|SLOC");
static_assert(WS_KT + (size_t)512 * 8192 * 4 <= WS_SCA, "kT overlays SLOC");
static_assert(WS_R + (size_t)MALL * 4096 * 2 <= WS_SEC_END, "r overlays the section");
static_assert(WS_GATE + (size_t)MALL * 1024 * 2 <= WS_UA, "gate inside PBUF");

constexpr int RING_BYTES = 131072;
constexpr int LDSCTL_OFF = 139264, MISC_OFF = LDSCTL_OFF + 320;
constexpr int LDS_BYTES = 147456;

constexpr int CW_BAR = 4096;
#define XB_TMO      128
#define XB_XCNT(j)  (256  + 64 * (j))
#define XB_XSUB(j)  (1280 + 64 * (j))
#define XB_XGEN(j)  (2304 + 64 * (j))
#define XB_TOP      3328
#define XB_TOPGEN   3392
#define XCD_BAR_WORDS 3456
#define XB_SPIN_CAP (1u << 18)

__device__ __forceinline__ unsigned xb_ld(unsigned* p)              { return __hip_atomic_load(p, __ATOMIC_RELAXED, __HIP_MEMORY_SCOPE_AGENT); }
__device__ __forceinline__ unsigned xb_add(unsigned* p, unsigned v) { return __hip_atomic_fetch_add(p, v, __ATOMIC_RELAXED, __HIP_MEMORY_SCOPE_AGENT); }
__device__ __forceinline__ unsigned xb_xcc_id() { return (unsigned)__builtin_amdgcn_s_getreg((3 << 11) | 20) & 0xFu; }
#define XB_SPIN(cond, bar) do { unsigned _sp = 0; while (cond) { __builtin_amdgcn_s_sleep(1); \
    if ((++_sp & 255u) == 0u) { if (xb_ld(&(bar)[XB_TMO])) break; if (_sp > XB_SPIN_CAP) { atomicAdd(&(bar)[XB_TMO], 1u); break; } } } } while (0)
struct XcdBarrier { unsigned* bar; unsigned x; volatile LAS unsigned* st; };
__device__ __forceinline__ XcdBarrier xcd_barrier_post(unsigned* bar, volatile LAS unsigned* st) {
    XcdBarrier b; b.bar = bar; b.x = xb_xcc_id(); b.st = st;
    if (threadIdx.x == 0) (void)xb_add(&bar[XB_XCNT(b.x)], 1u);
    return b;
}
__device__ __forceinline__ void xcd_barrier_complete(unsigned* bar, unsigned x, unsigned& nloc, unsigned& nx) {
    const unsigned G = gridDim.x * gridDim.y * gridDim.z;
    unsigned sum, cnt, mine, sp = 0u;
    for (;;) {
        sum = 0u; cnt = 0u; mine = 0u;
#pragma unroll
        for (unsigned j = 0; j < 16; ++j) { const unsigned c = xb_ld(&bar[XB_XCNT(j)]); sum += c; cnt += (c > 0u) ? 1u : 0u; mine = (j == x) ? c : mine; }
        if (sum == G) break;
        __builtin_amdgcn_s_sleep(1);
        if ((++sp & 255u) == 0u) { if (xb_ld(&bar[XB_TMO])) break; if (sp > XB_SPIN_CAP) { atomicAdd(&bar[XB_TMO], 1u); break; } }
    }
    nloc = mine > 0u ? mine : 1u; nx = cnt > 0u ? cnt : 1u;
}
__device__ __forceinline__ void xcd_barrier(const XcdBarrier& b) {
    asm volatile("s_waitcnt vmcnt(0)" ::: "memory");
    __syncthreads();
    if (threadIdx.x == 0) {
        unsigned* bar = b.bar;
        __builtin_amdgcn_s_waitcnt(0);
        unsigned nloc = b.st[0], nx = b.st[1];
        if (nloc == 0u) { xcd_barrier_complete(bar, b.x, nloc, nx); b.st[0] = nloc; b.st[1] = nx; }
        const unsigned old = xb_add(&bar[XB_XSUB(b.x)], 1u);
        const unsigned gen = old / nloc;
        if (old + 1u == (gen + 1u) * nloc) {
            __builtin_amdgcn_fence(__ATOMIC_RELEASE, "agent");
            asm volatile("s_waitcnt vmcnt(0)" ::: "memory");
            const unsigned og = xb_add(&bar[XB_TOP], 1u);
            const unsigned tg = og / nx;
            if (og + 1u == (tg + 1u) * nx) xb_add(&bar[XB_TOPGEN], 1u);
            else XB_SPIN(xb_ld(&bar[XB_TOPGEN]) == tg, bar);
            __builtin_amdgcn_fence(__ATOMIC_ACQUIRE, "agent");
            xb_add(&bar[XB_XGEN(b.x)], 1u);
            asm volatile("s_waitcnt vmcnt(0)" ::: "memory");
        } else {
            XB_SPIN(xb_ld(&bar[XB_XGEN(b.x)]) == gen, bar);
            __builtin_amdgcn_fence(__ATOMIC_ACQUIRE, "agent");
            asm volatile("s_waitcnt vmcnt(0)" ::: "memory");
        }
    }
    __syncthreads();
}

#define LDS_WAIT() asm volatile("s_waitcnt lgkmcnt(0)" ::: "memory")
#define VM_WAIT() asm volatile("s_waitcnt vmcnt(0)" ::: "memory")
__device__ __forceinline__ unsigned f2bf(float f) { unsigned u = __builtin_bit_cast(unsigned, f); return (u + 0x7fffu + ((u >> 16) & 1u)) >> 16; }
__device__ __forceinline__ unsigned pk2(float lo, float hi) { return f2bf(lo) | (f2bf(hi) << 16); }
__device__ __forceinline__ float bflo(unsigned w) { return __builtin_bit_cast(float, w << 16); }
__device__ __forceinline__ float bfhi(unsigned w) { return __builtin_bit_cast(float, w & 0xffff0000u); }
__device__ __forceinline__ float bf1(bf16_t h) { return __builtin_bit_cast(float, (unsigned)h << 16); }
__device__ __forceinline__ float sigm(float x) { return 1.f / (1.f + __expf(-x)); }
__device__ __forceinline__ float gelu_tanh(float x) { const float u = 0.7978845608028654f * (x + 0.044715f * x * x * x); const float e = __expf(2.f * u); return x * (1.f - 1.f / (1.f + e)); }
__device__ __forceinline__ float wave_sum(float v) {
#pragma unroll
    for (int o = 1; o < 64; o <<= 1) v += __shfl_xor(v, o);
    return v;
}

struct Args {
    const float* in[36]; float* out; unsigned char* ws; int ph_lo, ph_hi;
};
struct Frame {
    LAS unsigned char* lds; int tid, lane, wave, G, bid, gw, ngw;
    const float* const __attribute__((address_space(4)))* in; float* out; unsigned char* ws;
};
__device__ __forceinline__ float* xrow(const Frame& F, int row) { return row < ML ? F.out + (size_t)row * D : (float*)(F.ws + WS_XC) + (size_t)(row - ML) * D; }
__device__ __forceinline__ int modrow(int row) { return row < ML ? (row >> 12) : 4; }
__device__ __forceinline__ void urow_of(int row, int& ur, int& i) {
    if (row < ML) { ur = (row >> 12) * NCHL + ((row & 4095) >> 5); i = row & 31; }
    else { const int rc = row - ML; ur = NB * NCHL + (rc >> 8) * NCHC + ((rc & 255) >> 5); i = rc & 31; }
}
__device__ __forceinline__ int tok_of_urow(int ur) { return ur < NB * NCHL ? (ur >> 7) * SEQ + (ur & 127) * TCH : ML + ((ur - NB * NCHL) >> 3) * CTXL + ((ur - NB * NCHL) & 7) * TCH; }
using pg8::Unit;
using pg8::cvt_pk_bf16;
typedef f32x4 AccT[2][2][4][2];

__device__ __forceinline__ u32x4 pack8(const f32x4 v0, const f32x4 v1) { u32x4 w; w.x = cvt_pk_bf16(v0[0], v0[1]); w.y = cvt_pk_bf16(v0[2], v0[3]); w.z = cvt_pk_bf16(v1[0], v1[1]); w.w = cvt_pk_bf16(v1[2], v1[3]); return w; }

struct EpiBf16 {
    static constexpr bool PERM = true; bf16_t* O; int ldc;
    __device__ __forceinline__ void operator()(const AccT& acc, const Unit& u, int wr, int wc, int fr, int fq) const {
        const int row0 = u.pm * 256 + wr * 64 + fr, col0 = u.pn * 256 + wc * 32 + 8 * fq;
#pragma unroll
        for (int ai = 0; ai < 2; ++ai)
#pragma unroll
            for (int m = 0; m < 4; ++m) { bf16_t* rowp = O + (size_t)(row0 + ai * 128 + m * 16) * ldc + col0;
#pragma unroll
                for (int bj = 0; bj < 2; ++bj) *(u32x4*)(rowp + bj * 128) = pack8(acc[ai][bj][m][0], acc[ai][bj][m][1]); }
    }
};
struct EpiWinA {
    static constexpr bool PERM = true; bf16_t* UA; bf16_t* P;
    __device__ __forceinline__ void operator()(const AccT& acc, const Unit& u, int wr, int wc, int fr, int fq) const {
        const int row0 = u.pm * 256 + wr * 64 + fr;
        if (u.pn >= 2) {
            const int col0 = (u.pn - 2) * 256 + wc * 32 + 8 * fq;
#pragma unroll
            for (int ai = 0; ai < 2; ++ai)
#pragma unroll
                for (int m = 0; m < 4; ++m) { bf16_t* rowp = P + (size_t)(row0 + ai * 128 + m * 16) * 1536 + col0;
#pragma unroll
                    for (int bj = 0; bj < 2; ++bj) *(u32x4*)(rowp + bj * 128) = pack8(acc[ai][bj][m][0], acc[ai][bj][m][1]); }
        } else {
            const int q0 = 8 * (fq & 1), gb = 16 * u.pn + 2 * wc + (fq >> 1);
#pragma unroll
            for (int ai = 0; ai < 2; ++ai)
#pragma unroll
                for (int m = 0; m < 4; ++m) { int ur, i; urow_of(row0 + ai * 128 + m * 16, ur, i);
#pragma unroll
                    for (int bj = 0; bj < 2; ++bj) { const int g = gb + 8 * bj;
                        *(u32x4*)(UA + ((size_t)g * UROWS + ur) * UAK + i * 16 + q0) = pack8(acc[ai][bj][m][0], acc[ai][bj][m][1]); } }
        }
    }
};
struct EpiSloc {
    static constexpr bool PERM = false; float* S;
    __device__ __forceinline__ void operator()(const AccT& acc, const Unit& u, int wr, int wc, int fr, int fq) const {
        const int row0 = u.pm * 256 + wr * 64 + fr, col0 = wc * 32 + 4 * fq;
#pragma unroll
        for (int ai = 0; ai < 2; ++ai)
#pragma unroll
            for (int m = 0; m < 4; ++m) { const int r = row0 + ai * 128 + m * 16; if (r < UROWS) { float* rowp = S + ((size_t)u.g * UROWS + r) * 256 + col0;
#pragma unroll
                for (int bj = 0; bj < 2; ++bj)
#pragma unroll
                    for (int n = 0; n < 2; ++n) *(f32x4*)(rowp + bj * 128 + n * 16) = acc[ai][bj][m][n]; } }
    }
};
struct EpiYpre {
    static constexpr bool PERM = true; bf16_t* Y;
    __device__ __forceinline__ void operator()(const AccT& acc, const Unit& u, int wr, int wc, int fr, int fq) const {
        const int row0 = u.pm * 256 + wr * 64 + fr, p0 = 8 * (fq & 1), jb = 16 * u.pn + 2 * wc + (fq >> 1);
#pragma unroll
        for (int ai = 0; ai < 2; ++ai)
#pragma unroll
            for (int m = 0; m < 4; ++m) { const int r = row0 + ai * 128 + m * 16; if (r < UROWS) { const int tok0 = tok_of_urow(r);
#pragma unroll
                for (int bj = 0; bj < 2; ++bj) { const int j = jb + 8 * bj; f32x4 v0 = acc[ai][bj][m][0], v1 = acc[ai][bj][m][1];
#pragma unroll
                    for (int e = 0; e < 4; ++e) { v0[e] = gelu_tanh(v0[e]); v1[e] = gelu_tanh(v1[e]); }
                    *(u32x4*)(Y + (size_t)(tok0 + j) * 512 + u.g * 16 + p0) = pack8(v0, v1); } } }
    }
};
struct EpiGate {
    static constexpr bool PERM = true; bf16_t* O;
    __device__ __forceinline__ void operator()(const AccT& acc, const Unit& u, int wr, int wc, int fr, int fq) const {
        const int row0 = u.pm * 256 + wr * 64 + fr, col0 = u.pn * 256 + wc * 32 + 8 * fq;
#pragma unroll
        for (int ai = 0; ai < 2; ++ai)
#pragma unroll
            for (int m = 0; m < 4; ++m) { bf16_t* rowp = O + (size_t)(row0 + ai * 128 + m * 16) * 1024 + col0;
#pragma unroll
                for (int bj = 0; bj < 2; ++bj) { f32x4 v0 = acc[ai][bj][m][0], v1 = acc[ai][bj][m][1];
#pragma unroll
                    for (int e = 0; e < 4; ++e) { v0[e] = sigm(v0[e]); v1[e] = sigm(v1[e]); }
                    *(u32x4*)(rowp + bj * 128) = pack8(v0, v1); } }
    }
};
__device__ __forceinline__ void unpack8(const u32x4 w, f32x4& a, f32x4& b) { a = (f32x4){bflo(w.x), bfhi(w.x), bflo(w.y), bfhi(w.y)}; b = (f32x4){bflo(w.z), bfhi(w.z), bflo(w.w), bfhi(w.w)}; }
template <int MODE> struct EpiBranch {
    static constexpr bool PERM = true; bf16_t* M; const bf16_t* Gt;
    __device__ __forceinline__ void operator()(const AccT& acc, const Unit& u, int wr, int wc, int fr, int fq) const {
        const int row0 = u.pm * 256 + wr * 64 + fr;
        if (MODE == 0) {
            const int col0 = u.pn * 128 + wc * 32 + 8 * fq;
#pragma unroll
            for (int ai = 0; ai < 2; ++ai)
#pragma unroll
                for (int m = 0; m < 4; ++m) { const size_t o = (size_t)(row0 + ai * 128 + m * 16) * 1024 + col0;
                    f32x4 g0, g1; unpack8(*(const u32x4*)(Gt + o), g0, g1);
                    f32x4 v0 = acc[ai][0][m][0], v1 = acc[ai][0][m][1]; const f32x4 s0 = acc[ai][1][m][0], s1 = acc[ai][1][m][1];
#pragma unroll
                    for (int e = 0; e < 4; ++e) { v0[e] = g0[e] * v0[e] * sigm(s0[e]); v1[e] = g1[e] * v1[e] * sigm(s1[e]); }
                    *(u32x4*)(M + o) = pack8(v0, v1); }
        } else {
            const int col0 = u.pn * 256 + wc * 32 + 8 * fq;
#pragma unroll
            for (int ai = 0; ai < 2; ++ai)
#pragma unroll
                for (int m = 0; m < 4; ++m)
#pragma unroll
                    for (int bj = 0; bj < 2; ++bj) { const size_t o = (size_t)(row0 + ai * 128 + m * 16) * 1024 + col0 + bj * 128;
                        f32x4 g0, g1, m0, m1; unpack8(*(const u32x4*)(Gt + o), g0, g1); unpack8(*(const u32x4*)(M + o), m0, m1);
                        const f32x4 v0 = m0 + g0 * acc[ai][bj][m][0], v1 = m1 + g1 * acc[ai][bj][m][1];
                        *(u32x4*)(M + o) = pack8(v0, v1); }
        }
    }
};
struct EpiResid {
    static constexpr bool PERM = false; float* xl; float* xc; const float* gm;
    __device__ __forceinline__ void operator()(const AccT& acc, const Unit& u, int wr, int wc, int fr, int fq) const {
        const int rt = u.pm * 256; float* base = rt < ML ? xl + (size_t)rt * 1024 : xc + (size_t)(rt - ML) * 1024;
        const float* gv = gm + (size_t)(rt < ML ? (rt >> 12) : 4) * NMOD;
        const int rl = wr * 64 + fr, col0 = u.pn * 256 + wc * 32 + 4 * fq;
        f32x4 gg[2][2];
#pragma unroll
        for (int bj = 0; bj < 2; ++bj)
#pragma unroll
            for (int n = 0; n < 2; ++n) gg[bj][n] = *(const f32x4*)(gv + col0 + bj * 128 + n * 16);
#pragma unroll
        for (int ai = 0; ai < 2; ++ai)
#pragma unroll
            for (int m = 0; m < 4; ++m) { float* rowp = base + (size_t)(rl + ai * 128 + m * 16) * 1024 + col0;
#pragma unroll
                for (int bj = 0; bj < 2; ++bj)
#pragma unroll
                    for (int n = 0; n < 2; ++n) { f32x4* p = (f32x4*)(rowp + bj * 128 + n * 16); *p = *p + gg[bj][n] * acc[ai][bj][m][n]; } }
    }
};
struct EpiRelu2 {
    static constexpr bool PERM = true; bf16_t* O;
    __device__ __forceinline__ void operator()(const AccT& acc, const Unit& u, int wr, int wc, int fr, int fq) const {
        const int row0 = u.pm * 256 + wr * 64 + fr, col0 = u.pn * 256 + wc * 32 + 8 * fq;
#pragma unroll
        for (int ai = 0; ai < 2; ++ai)
#pragma unroll
            for (int m = 0; m < 4; ++m) { bf16_t* rowp = O + (size_t)(row0 + ai * 128 + m * 16) * 4096 + col0;
#pragma unroll
                for (int bj = 0; bj < 2; ++bj) { f32x4 v0 = acc[ai][bj][m][0], v1 = acc[ai][bj][m][1];
#pragma unroll
                    for (int e = 0; e < 4; ++e) { const float a = fmaxf(v0[e], 0.f), b = fmaxf(v1[e], 0.f); v0[e] = a * a; v1[e] = b * b; }
                    *(u32x4*)(rowp + bj * 128) = pack8(v0, v1); } }
    }
};
#define FFT_HD __device__ __forceinline__
typedef float cf __attribute__((ext_vector_type(2)));
FFT_HD cf cadd(cf a, cf b) { return a + b; }
FFT_HD cf csub(cf a, cf b) { return a - b; }
FFT_HD cf cmul(cf a, cf b) { return (cf){a.x * b.x - a.y * b.y, a.x * b.y + a.y * b.x}; }
FFT_HD cf cmulmi(cf a) { return (cf){a.y, -a.x}; }
FFT_HD void dft4(cf& a0, cf& a1, cf& a2, cf& a3) {
    const cf t0 = cadd(a0, a2), t1 = csub(a0, a2), t2 = cadd(a1, a3), t3 = cmulmi(csub(a1, a3));
    a0 = cadd(t0, t2); a2 = csub(t0, t2); a1 = cadd(t1, t3); a3 = csub(t1, t3);
}
FFT_HD void dft8(cf* v) {
    cf e0 = v[0], e1 = v[2], e2 = v[4], e3 = v[6], o0 = v[1], o1 = v[3], o2 = v[5], o3 = v[7];
    dft4(e0, e1, e2, e3); dft4(o0, o1, o2, o3);
    const float h = 0.70710678118654752f;
    const cf w1o = (cf){h * (o1.x + o1.y), h * (o1.y - o1.x)};
    const cf w2o = cmulmi(o2);
    const cf w3o = (cf){h * (o3.y - o3.x), -h * (o3.x + o3.y)};
    v[0] = cadd(e0, o0); v[4] = csub(e0, o0);
    v[1] = cadd(e1, w1o); v[5] = csub(e1, w1o);
    v[2] = cadd(e2, w2o); v[6] = csub(e2, w2o);
    v[3] = cadd(e3, w3o); v[7] = csub(e3, w3o);
}
FFT_HD void dft16(cf* v) {
    cf e[8], o[8];
#pragma unroll
    for (int i = 0; i < 8; ++i) { e[i] = v[2 * i]; o[i] = v[2 * i + 1]; }
    dft8(e); dft8(o);
    const float c1 = 0.92387953251128674f, s1 = 0.38268343236508977f, h = 0.70710678118654752f;
    const cf w[8] = {(cf){1.f, 0.f}, (cf){c1, -s1}, (cf){h, -h}, (cf){s1, -c1}, (cf){0.f, -1.f}, (cf){-s1, -c1}, (cf){-h, -h}, (cf){-c1, -s1}};
#pragma unroll
    for (int k = 0; k < 8; ++k) { const cf t = cmul(o[k], w[k]); v[k] = cadd(e[k], t); v[k + 8] = csub(e[k], t); }
}
template <int R, int LOGS, int LOGN> __device__ __forceinline__ void fft_pass(LAS cf* buf, const LAS cf* tw, int tid) {
    constexpr int NBF = 8192 / R, BPT = NBF / NTHREADS;
    cf v[BPT][R];
#pragma unroll
    for (int b = 0; b < BPT; ++b)
#pragma unroll
        for (int r = 0; r < R; ++r) v[b][r] = buf[tid + NTHREADS * b + NBF * r];
    LDS_WAIT(); __syncthreads();
#pragma unroll
    for (int b = 0; b < BPT; ++b) {
        const int j = tid + NTHREADS * b, p = j >> LOGS, q = j & ((1 << LOGS) - 1);
        if (R == 8) dft8(v[b]); else dft16(v[b]);
        LAS cf* o = buf + q + ((p * R) << LOGS);
        o[0] = v[b][0];
        if (LOGN > 4) {
            const cf w1 = tw[p << (13 - LOGN)]; cf w = w1;
#pragma unroll
            for (int k = 1; k < R; ++k) { o[k << LOGS] = cmul(v[b][k], w); w = cmul(w, w1); }
        } else {
#pragma unroll
            for (int k = 1; k < R; ++k) o[k << LOGS] = v[b][k];
        }
    }
    LDS_WAIT(); __syncthreads();
}
__device__ __forceinline__ void fft8192(LAS cf* buf, const LAS cf* tw, int tid) {
    fft_pass<8, 0, 13>(buf, tw, tid); fft_pass<8, 3, 10>(buf, tw, tid); fft_pass<8, 6, 7>(buf, tw, tid); fft_pass<16, 9, 4>(buf, tw, tid);
}

__device__ __forceinline__ void ph_pre(Frame& F) {
    LAS float* sv = (LAS float*)F.lds; LAS float* red = sv + 5 * 1024;
    const float* c = F.in[1]; const float* c_ctx = F.in[3]; const float* ada_w = F.in[4]; const float* ada_b = F.in[5];
    float* mod = (float*)(F.ws + WS_MOD);
    for (int i = F.tid; i < 5 * 1024; i += NTHREADS) { const int r = i >> 10, k = i & 1023; const float x = r < 4 ? c[r * 1024 + k] : c_ctx[k]; sv[i] = x / (1.f + expf(-x)); }
    __syncthreads();
    for (int unit = F.bid; unit < 2 * 96; unit += F.G) {
        const int l = unit / 96, n0 = (unit % 96) * 64;
        const float* W = ada_w + (size_t)l * 1024 * NMOD + n0 + F.lane;
        float a0 = 0.f, a1 = 0.f, a2 = 0.f, a3 = 0.f, a4 = 0.f;
        const int k0 = F.wave * 128;
#pragma unroll 8
        for (int k = k0; k < k0 + 128; ++k) { const float w = W[(size_t)k * NMOD]; a0 += sv[k] * w; a1 += sv[1024 + k] * w; a2 += sv[2048 + k] * w; a3 += sv[3072 + k] * w; a4 += sv[4096 + k] * w; }
        red[(F.wave * 5 + 0) * 64 + F.lane] = a0; red[(F.wave * 5 + 1) * 64 + F.lane] = a1; red[(F.wave * 5 + 2) * 64 + F.lane] = a2; red[(F.wave * 5 + 3) * 64 + F.lane] = a3; red[(F.wave * 5 + 4) * 64 + F.lane] = a4;
        __syncthreads();
        if (F.tid < 320) { const int r = F.tid >> 6, ln = F.tid & 63; float s = 0.f;
#pragma unroll
            for (int w = 0; w < 8; ++w) s += red[(w * 5 + r) * 64 + ln];
            mod[((size_t)l * 5 + r) * NMOD + n0 + ln] = s + ada_b[l * NMOD + n0 + ln]; }
        __syncthreads();
    }
    float* pos = (float*)(F.ws + WS_POS);
    for (int i = F.bid * NTHREADS + F.tid; i < 64 * 512; i += F.G * NTHREADS) {
        const int p = i >> 9, d = i & 511, isc = d >> 8, k = d & 255;
        const float omega = 1.0f / powf(10000.0f, (float)k / 256.0f), a = (float)p * omega;
        pos[i] = isc ? cosf(a) : sinf(a);
    }
}

__device__ __forceinline__ void transpose_item(const float* W, int K, int N, bf16_t* WT, int glu, LAS float* scr, int item, int lane) {
    const int nblk = N / 32, kb = item / nblk, nb = item % nblk, k0 = 64 * kb, n0 = 32 * nb;
    { f32x4 v[8];
#pragma unroll
      for (int i = 0; i < 8; ++i) v[i] = *(const f32x4*)(W + (size_t)(k0 + 8 * i + (lane >> 3)) * N + n0 + 4 * (lane & 7));
#pragma unroll
      for (int i = 0; i < 8; ++i) { LAS float* d = scr + (8 * i + (lane >> 3)) * 33 + 4 * (lane & 7); d[0] = v[i][0]; d[1] = v[i][1]; d[2] = v[i][2]; d[3] = v[i][3]; } }
    LDS_WAIT(); asm volatile("" ::: "memory");
    const int n0p = glu ? (((n0 & 1023) >> 7) * 256 + (n0 >> 10) * 128 + (n0 & 127)) : n0;
    const int c = lane & 7;
#pragma unroll
    for (int j = 0; j < 4; ++j) { const int n = (lane >> 3) + 8 * j; const LAS float* s = scr + (8 * c) * 33 + n;
        u32x4 o; o.x = pk2(s[0 * 33], s[1 * 33]); o.y = pk2(s[2 * 33], s[3 * 33]); o.z = pk2(s[4 * 33], s[5 * 33]); o.w = pk2(s[6 * 33], s[7 * 33]);
        *(u32x4*)(WT + (size_t)(n0p + n) * K + k0 + 8 * c) = o; }
    LDS_WAIT(); asm volatile("" ::: "memory");
}
__device__ __forceinline__ void h3_row(const Frame& F, int t, int L, float* H3, const LAS float* wts, LAS float* scr) {
    const LAS float* w1 = wts; const LAS float* w2 = wts + 2112; const LAS float* w3 = w2 + 4096; const LAS float* bs = w3 + 4096;
    const int j = F.lane;
    LAS float* z = scr; LAS float* h = scr + 64; LAS float* h2 = scr + 128;
    if (j == 0) z[0] = (float)t / (float)(L - 1);
    if (j < 16) { const float band = 1e-4f + (float)j * ((15.0f - 1e-4f) / 15.0f), ang = 6.283185307179586f * (float)t / (float)L; z[1 + j] = cosf(band * ang); z[17 + j] = -sinf(band * ang); }
    LDS_WAIT(); asm volatile("" ::: "memory");
    const float f = bs[192 + j];
    float a = bs[j];
#pragma unroll 3
    for (int i = 0; i < 33; ++i) a += z[i] * w1[i * 64 + j];
    h[j] = sinf(f * a); LDS_WAIT(); asm volatile("" ::: "memory");
    a = bs[64 + j];
#pragma unroll 8
    for (int i = 0; i < 64; ++i) a += h[i] * w2[i * 64 + j];
    h2[j] = sinf(f * a); LDS_WAIT(); asm volatile("" ::: "memory");
    a = bs[128 + j];
#pragma unroll 8
    for (int i = 0; i < 64; ++i) a += h2[i] * w3[i * 64 + j];
    H3[(size_t)t * 64 + j] = sinf(f * a);
    LDS_WAIT(); asm volatile("" ::: "memory");
}
template <bool INIT> __device__ __forceinline__ void norm_load(const Frame& F, int row, f32x4 (&v)[4]) {
    float* xs = xrow(F, row);
    if (INIT) {
        if (row < ML) { const float* src = F.in[0] + (size_t)row * D; const float* pos = (const float*)(F.ws + WS_POS); const int t = row & 4095, pr = t >> 6, pc = t & 63;
#pragma unroll
            for (int j = 0; j < 4; ++j) { const int d = 4 * F.lane + 256 * j; const f32x4 e = *(const f32x4*)(pos + (size_t)(d < 512 ? pr : pc) * 512 + (d & 511)); v[j] = *(const f32x4*)(src + d) + e; *(f32x4*)(xs + d) = v[j]; } }
        else { const float* src = F.in[2] + (size_t)(row - ML) * D;
#pragma unroll
            for (int j = 0; j < 4; ++j) { const int d = 4 * F.lane + 256 * j; v[j] = *(const f32x4*)(src + d); *(f32x4*)(xs + d) = v[j]; } }
    } else {
#pragma unroll
        for (int j = 0; j < 4; ++j) v[j] = *(const f32x4*)(xs + 4 * F.lane + 256 * j);
    }
}
__device__ __forceinline__ void norm_store(const Frame& F, int row, const f32x4 (&v)[4], const float* g, const float* modl, int shoff, bf16_t* Hout) {
    float s = 0.f;
#pragma unroll
    for (int j = 0; j < 4; ++j) s += (v[j][0] * v[j][0] + v[j][1] * v[j][1]) + (v[j][2] * v[j][2] + v[j][3] * v[j][3]);
    const float rs = rsqrtf(wave_sum(s) * (1.f / D) + EPS);
    const float* mv = modl + (size_t)modrow(row) * NMOD + shoff;
#pragma unroll
    for (int j = 0; j < 4; ++j) { const int d = 4 * F.lane + 256 * j; const f32x4 gg = *(const f32x4*)(g + d), sh = *(const f32x4*)(mv + d), sc = *(const f32x4*)(mv + 1024 + d);
        const f32x4 y = (v[j] * rs) * gg * (sc + 1.f) + sh;
        u32x2 w; w.x = pk2(y[0], y[1]); w.y = pk2(y[2], y[3]); *(u32x2*)(Hout + (size_t)row * D + d) = w; }
}
template <bool INIT> __device__ __forceinline__ void norm_rows(const Frame& F, int nrows, int wv, int nw, const float* g, const float* modl, int shoff, bf16_t* Hout) {
    for (int row = 2 * wv; row < nrows; row += 2 * nw) {
        f32x4 va[4], vb[4];
        norm_load<INIT>(F, row, va); norm_load<INIT>(F, row + 1, vb);
        norm_store(F, row, va, g, modl, shoff, Hout); norm_store(F, row + 1, vb, g, modl, shoff, Hout);
    }
}
__device__ __forceinline__ void s5_mats(const Frame& F, int l, int g) {
    LAS float* L = (LAS float*)F.lds;
    LAS float* pwr = L;
    LAS float* pwi = pwr + 2 * 33 * 64;
    LAS float* bbr = pwi + 2 * 33 * 64;
    LAS float* bbi = bbr + 2048;
    LAS float* ccr = bbi + 2048;
    LAS float* cci = ccr + 2048;
    LAS float* kt = cci + 2048;
    LAS float* dv = kt + 16384;
    const float* a_re = F.in[9] + l * 4096; const float* a_im = F.in[10] + l * 4096; const float* log_dt = F.in[11] + l * 64;
    const float* b_re = F.in[12] + (size_t)l * 65536; const float* b_im = F.in[13] + (size_t)l * 65536; const float* c_re = F.in[14] + (size_t)l * 65536; const float* c_im = F.in[15] + (size_t)l * 65536;
    const int tid = F.tid;
    if (tid < 128) {
        const int k = tid >> 6, n = tid & 63, kg = k * 32 + g;
        const float are = a_re[kg * 64 + n], aim = a_im[kg * 64 + n], dt = expf(log_dt[kg]);
        const float mag = expf(are * dt), ang = aim * dt, abr = mag * cosf(ang), abi = mag * sinf(ang);
        const float den = are * are + aim * aim, nr = abr - 1.f, ni = abi;
        const float fre = (nr * are + ni * aim) / den, fim = (ni * are - nr * aim) / den;
        for (int q = 0; q < 16; ++q) { const float br = b_re[((size_t)kg * 64 + n) * 16 + q], bi = b_im[((size_t)kg * 64 + n) * 16 + q];
            bbr[(k * 64 + n) * 16 + q] = fre * br - fim * bi; bbi[(k * 64 + n) * 16 + q] = fre * bi + fim * br; }
        float pr = 1.f, pi = 0.f;
        for (int e = 0; e <= 32; ++e) { pwr[(k * 33 + e) * 64 + n] = pr; pwi[(k * 33 + e) * 64 + n] = pi; const float t = pr * abr - pi * abi; pi = pr * abi + pi * abr; pr = t; }
        float* ap = (float*)(F.ws + WS_APOW) + ((size_t)(g * 2 + k) * 64 + n) * 2;
        ap[0] = pwr[(k * 33 + 32) * 64 + n]; ap[1] = pwi[(k * 33 + 32) * 64 + n];
    } else if (tid < 144) { dv[tid - 128] = F.in[16][l * 512 + g * 16 + (tid - 128)]; }
    for (int i = tid; i < 2048; i += NTHREADS) { const int k = i >> 10, p = (i >> 6) & 15, n = i & 63; const size_t o = ((size_t)(k * 32 + g) * 16 + p) * 64 + n; ccr[i] = c_re[o]; cci[i] = c_im[o]; }
    LDS_WAIT(); __syncthreads();
    {
        const int k = tid >> 8, pq = tid & 255, p = pq >> 4, q = pq & 15;
#pragma unroll 1
        for (int hf = 0; hf < 2; ++hf) {
            const int n0 = hf * 32;
            float gr[32], gi[32];
#pragma unroll
            for (int n = 0; n < 32; ++n) { const float cr = ccr[(k * 16 + p) * 64 + n0 + n], ci = cci[(k * 16 + p) * 64 + n0 + n], br = bbr[(k * 64 + n0 + n) * 16 + q], bi = bbi[(k * 64 + n0 + n) * 16 + q];
                gr[n] = cr * br - ci * bi; gi[n] = cr * bi + ci * br; }
#pragma unroll 1
            for (int tau = 0; tau < 32; ++tau) {
                const LAS f32x4* pr = (const LAS f32x4*)(pwr + (k * 33 + tau) * 64 + n0); const LAS f32x4* pi = (const LAS f32x4*)(pwi + (k * 33 + tau) * 64 + n0);
                float s0 = 0.f, s1 = 0.f;
#pragma unroll
                for (int n4 = 0; n4 < 8; ++n4) { const f32x4 a = pr[n4], b = pi[n4];
#pragma unroll
                    for (int e = 0; e < 4; ++e) { s0 += gr[n4 * 4 + e] * a[e]; s1 += gi[n4 * 4 + e] * b[e]; } }
                LAS float* dst = kt + (k * 32 + tau) * 256 + pq;
                if (hf == 0) *dst = s0 - s1; else *dst += s0 - s1;
            }
        }
    }
    LDS_WAIT(); __syncthreads();
    bf16_t* BTB = (bf16_t*)(F.ws + WS_BTB) + (size_t)g * 512 * UAK;
    for (int it = 0; it < 64; ++it) {
        const int row = it * 8 + (tid >> 6), c8 = tid & 63, j = row >> 4, p = row & 15, i = c8 >> 1, q0 = (c8 & 1) * 8;
        float v[8];
        if (i < j) { const LAS float* s = kt + ((0 * 32 + (j - i)) * 16 + p) * 16 + q0;
#pragma unroll
            for (int e = 0; e < 8; ++e) v[e] = s[e]; }
        else if (i > j) { const LAS float* s = kt + ((1 * 32 + (i - j)) * 16 + p) * 16 + q0;
#pragma unroll
            for (int e = 0; e < 8; ++e) v[e] = s[e]; }
        else { const LAS float* s0 = kt + (p * 16) + q0; const LAS float* s1 = kt + ((32 * 16 + p) * 16) + q0;
#pragma unroll
            for (int e = 0; e < 8; ++e) v[e] = s0[e] + s1[e] + ((q0 + e == p) ? dv[p] : 0.f); }
        u32x4 o; o.x = pk2(v[0], v[1]); o.y = pk2(v[2], v[3]); o.z = pk2(v[4], v[5]); o.w = pk2(v[6], v[7]);
        *(u32x4*)(BTB + (size_t)row * UAK + c8 * 8) = o;
    }
    for (int it = 0; it < 32; ++it) {
        const int id = it * NTHREADS + tid, row = id >> 5, ch = id & 31, j = row >> 4, p = row & 15, k = ch >> 4, n0 = (ch & 15) * 4, e = k ? (32 - j) : (j + 1);
        float v[8];
#pragma unroll
        for (int d = 0; d < 4; ++d) { const int n = n0 + d; const float cr = ccr[(k * 16 + p) * 64 + n], ci = cci[(k * 16 + p) * 64 + n], pr = pwr[(k * 33 + e) * 64 + n], pi = pwi[(k * 33 + e) * 64 + n];
            v[2 * d] = cr * pr - ci * pi; v[2 * d + 1] = -(cr * pi + ci * pr); }
        u32x4 o; o.x = pk2(v[0], v[1]); o.y = pk2(v[2], v[3]); o.z = pk2(v[4], v[5]); o.w = pk2(v[6], v[7]);
        *(u32x4*)(BTB + (size_t)row * UAK + 512 + ch * 8) = o;
    }
    bf16_t* WST = (bf16_t*)(F.ws + WS_WST) + (size_t)g * 256 * 512;
    for (int it = 0; it < 32; ++it) {
        const int id = it * NTHREADS + tid, s = id >> 6, c8 = id & 63, k = s >> 7, n = (s >> 1) & 63, ri = s & 1, i = c8 >> 1, q0 = (c8 & 1) * 8, e = k ? i : (31 - i);
        const float pr = pwr[(k * 33 + e) * 64 + n], pi = pwi[(k * 33 + e) * 64 + n];
        float v[8];
#pragma unroll
        for (int d = 0; d < 8; ++d) { const float br = bbr[(k * 64 + n) * 16 + q0 + d], bi = bbi[(k * 64 + n) * 16 + q0 + d]; v[d] = ri ? (pr * bi + pi * br) : (pr * br - pi * bi); }
        u32x4 o; o.x = pk2(v[0], v[1]); o.y = pk2(v[2], v[3]); o.z = pk2(v[4], v[5]); o.w = pk2(v[6], v[7]);
        *(u32x4*)(WST + (size_t)s * 512 + c8 * 8) = o;
    }
    LDS_WAIT(); __syncthreads();
}
template <int LAYER> __device__ __forceinline__ void ph_layer_prep(Frame& F) {
    constexpr int l = LAYER;
    const bool split = F.G > 64;
#ifndef NO_S5M
    if (F.bid < 32) { s5_mats(F, l, F.bid); if (split) return; }
#endif
    const int wv = split ? F.gw - 32 * NWAVES : F.gw, nw = split ? F.ngw - 32 * NWAVES : F.ngw;
    LAS float* scr = (LAS float*)(F.lds + F.wave * 8704);
    LAS float* wts = (LAS float*)(F.lds + 69632);
    LAS float* hs = (LAS float*)(F.lds + 112640 + F.wave * 1024);
    {
        const float* w1 = F.in[22] + l * 33 * 64; const float* w2 = F.in[24] + l * 4096; const float* w3 = F.in[26] + l * 4096;
        for (int i = F.tid; i < 2112; i += NTHREADS) wts[i] = w1[i];
        for (int i = F.tid; i < 4096; i += NTHREADS) { wts[2112 + i] = w2[i]; wts[2112 + 4096 + i] = w3[i]; }
        if (F.tid < 64) { wts[10304 + F.tid] = F.in[23][l * 64 + F.tid]; wts[10304 + 64 + F.tid] = F.in[25][l * 64 + F.tid]; wts[10304 + 128 + F.tid] = F.in[27][l * 64 + F.tid]; wts[10304 + 192 + F.tid] = F.in[28][l * 64 + F.tid]; }
        LDS_WAIT(); __syncthreads();
    }
    constexpr int I_IN = 16 * 208, I_GLU = 8 * 64, I_SC = 8 * 32, I_HY = 8 * 32, I_OUT = 16 * 32, I_1 = 16 * 128, I_2 = 64 * 32;
    constexpr int NIT = I_IN + I_GLU + I_SC + I_HY + I_OUT + I_1 + I_2;
#ifndef NO_TR
    for (int it = wv; it < NIT; it += nw) {
        int r = it;
        if (r < I_IN) { transpose_item(F.in[8] + (size_t)l * 1024 * 6656, 1024, 6656, (bf16_t*)(F.ws + WS_WIN), 0, scr, r, F.lane); continue; } r -= I_IN;
        if (r < I_GLU) { transpose_item(F.in[17] + (size_t)l * 512 * 2048, 512, 2048, (bf16_t*)(F.ws + WS_WGLU), 1, scr, r, F.lane); continue; } r -= I_GLU;
        if (r < I_SC) { transpose_item(F.in[19] + (size_t)l * 512 * 1024, 512, 1024, (bf16_t*)(F.ws + WS_WSC), 0, scr, r, F.lane); continue; } r -= I_SC;
        if (r < I_HY) { transpose_item(F.in[31] + (size_t)l * 512 * 1024, 512, 1024, (bf16_t*)(F.ws + WS_WHY), 0, scr, r, F.lane); continue; } r -= I_HY;
        if (r < I_OUT) { transpose_item(F.in[32] + (size_t)l * 1024 * 1024, 1024, 1024, (bf16_t*)(F.ws + WS_WOUT), 0, scr, r, F.lane); continue; } r -= I_OUT;
        if (r < I_1) { transpose_item(F.in[33] + (size_t)l * 1024 * 4096, 1024, 4096, (bf16_t*)(F.ws + WS_W1), 0, scr, r, F.lane); continue; } r -= I_1;
        transpose_item(F.in[34] + (size_t)l * 4096 * 1024, 4096, 1024, (bf16_t*)(F.ws + WS_W2), 0, scr, r, F.lane);
    }
#endif
#ifndef NO_H3
    for (int t = wv; t < SEQ + (l == 0 ? CTXL : 0); t += nw) {
        if (t < SEQ) h3_row(F, t, SEQ, (float*)(F.ws + WS_H3), wts, hs); else h3_row(F, t - SEQ, CTXL, (float*)(F.ws + WS_H3C), wts, hs);
    }
#endif
    const float* modl = (const float*)(F.ws + WS_MOD) + (size_t)l * 5 * NMOD;
#ifndef NO_NORM
    norm_rows<l == 0>(F, MALL, wv, nw, F.in[6] + l * D, modl, 0, (bf16_t*)(F.ws + WS_H));
#endif
}

__device__ __forceinline__ void ph_prep_sc(Frame& F, int l, int nrows) {
    const bf16_t* P = (const bf16_t*)(F.ws + WS_PBUF); bf16_t* O = (bf16_t*)(F.ws + WS_SCA); const float* w = F.in[18] + l * 1536;
    const int cg = F.tid & 63, rr = F.tid >> 6, c0 = cg * 8;
    float w0[8], w1[8], w2[8];
#pragma unroll
    for (int e = 0; e < 8; ++e) { w0[e] = w[c0 + e]; w1[e] = w[512 + c0 + e]; w2[e] = w[1024 + c0 + e]; }
    for (int blk = F.bid; blk < nrows / 64; blk += F.G) {
        const int r0 = blk * 64 + rr * 8;
        const int s0 = r0 < ML ? (r0 & ~4095) : (ML + ((r0 - ML) & ~255)), s1 = s0 + (r0 < ML ? SEQ : CTXL);
        float pa[8], pb[8], pc[8];
        auto prod = [&](int row, float* o) {
            if (row < s0 || row >= s1) {
#pragma unroll
                for (int e = 0; e < 8; ++e) o[e] = 0.f;
                return; }
            const u32x4 xv = *(const u32x4*)(P + (size_t)row * 1536 + c0), cv = *(const u32x4*)(P + (size_t)row * 1536 + 1024 + c0);
            f32x4 x0, x1, q0, q1; unpack8(xv, x0, x1); unpack8(cv, q0, q1);
#pragma unroll
            for (int e = 0; e < 4; ++e) { o[e] = x0[e] * q0[e]; o[4 + e] = x1[e] * q1[e]; }
        };
        prod(r0 - 1, pa); prod(r0, pb);
#pragma unroll 1
        for (int k = 0; k < 8; ++k) {
            const int row = r0 + k;
            prod(row + 1, pc);
            f32x4 b0, b1; unpack8(*(const u32x4*)(P + (size_t)row * 1536 + 512 + c0), b0, b1);
            float y[8];
#pragma unroll
            for (int e = 0; e < 8; ++e) y[e] = (e < 4 ? b0[e] : b1[e - 4]) * (w0[e] * pa[e] + w1[e] * pb[e] + w2[e] * pc[e]);
            u32x4 o; o.x = pk2(y[0], y[1]); o.y = pk2(y[2], y[3]); o.z = pk2(y[4], y[5]); o.w = pk2(y[6], y[7]);
            *(u32x4*)(O + (size_t)row * 512 + c0) = o;
#pragma unroll
            for (int e = 0; e < 8; ++e) { pa[e] = pb[e]; pb[e] = pc[e]; }
        }
    }
}
__device__ __forceinline__ void ph_prep_hy(Frame& F, int l, int ntiles) {
    const bf16_t* P = (const bf16_t*)(F.ws + WS_PBUF); bf16_t* X0 = (bf16_t*)(F.ws + WS_X0); bf16_t* UT = (bf16_t*)(F.ws + WS_UT); bf16_t* UTC = (bf16_t*)(F.ws + WS_UTC);
    const float* w = F.in[20] + l * 4608; const float* bias = F.in[21] + l * 1536;
    LAS bf16_t* ut = (LAS bf16_t*)F.lds;
    const int cg = F.tid & 7, rr = F.tid >> 3;
    for (int unit = F.bid; unit < ntiles * 8; unit += F.G) {
        const int pm = unit >> 3, cb = unit & 7, cbase = cb * 64 + cg * 8, rt = pm * 256, r0 = rt + rr * 4;
        const bool lo_ok = (pm < 64) && ((pm & 15) != 0), hi_ok = (pm < 64) && ((pm & 15) != 15);
        float qv[4][8];
#pragma unroll
        for (int pi = 0; pi < 3; ++pi) {
            const int part = pi == 0 ? 2 : pi - 1;
            const int col = part * 512 + cbase;
            float wa[8], wb[8], wc[8], bb[8];
#pragma unroll
            for (int e = 0; e < 8; ++e) { wa[e] = w[col + e]; wb[e] = w[1536 + col + e]; wc[e] = w[3072 + col + e]; bb[e] = bias[col + e]; }
            float rows[6][8];
#pragma unroll
            for (int k = 0; k < 6; ++k) { const int row = r0 - 1 + k; const bool ok = (row >= rt || lo_ok) && (row < rt + 256 || hi_ok);
                if (ok) { f32x4 a, b; unpack8(*(const u32x4*)(P + (size_t)row * 1536 + col), a, b);
#pragma unroll
                    for (int e = 0; e < 4; ++e) { rows[k][e] = a[e]; rows[k][4 + e] = b[e]; } }
                else {
#pragma unroll
                    for (int e = 0; e < 8; ++e) rows[k][e] = 0.f; } }
#pragma unroll
            for (int k = 0; k < 4; ++k) {
                float qk[8];
#pragma unroll
                for (int e = 0; e < 8; ++e) qk[e] = wa[e] * rows[k][e] + wb[e] * rows[k + 1][e] + wc[e] * rows[k + 2][e] + bb[e];
                if (part == 2) { u32x4 o; o.x = pk2(qk[0], qk[1]); o.y = pk2(qk[2], qk[3]); o.z = pk2(qk[4], qk[5]); o.w = pk2(qk[6], qk[7]); *(u32x4*)(X0 + (size_t)(r0 + k) * 512 + cbase) = o; }
                else if (part == 0) {
#pragma unroll
                    for (int e = 0; e < 8; ++e) qv[k][e] = qk[e]; }
                else {
#pragma unroll
                    for (int e = 0; e < 8; ++e) ut[(cg * 8 + e) * 264 + rr * 4 + k] = (bf16_t)f2bf(qk[e] * qv[k][e]); }
            }
        }
        LDS_WAIT(); __syncthreads();
#pragma unroll
        for (int it = 0; it < 4; ++it) { const int id = it * NTHREADS + F.tid, ch = id >> 5, pc = id & 31;
            const u32x4 v = *(const LAS u32x4*)(ut + ch * 264 + pc * 8);
            bf16_t* dst = pm < 64 ? UT + (size_t)(cb * 64 + ch) * ML + rt + pc * 8 : UTC + (size_t)(cb * 64 + ch) * MC + (rt - ML) + pc * 8;
            *(u32x4*)dst = v; }
        LDS_WAIT(); __syncthreads();
    }
}
__device__ __forceinline__ void s5_chain(Frame& F, int g) {
    const int n = F.tid & 63, k = (F.tid >> 6) & 1, b = F.tid >> 7;
    const float* ap = (const float*)(F.ws + WS_APOW) + ((size_t)(g * 2 + k) * 64 + n) * 2; const float ar = ap[0], ai = ap[1];
    const float* S = (const float*)(F.ws + WS_SLOC) + (size_t)g * UROWS * 256 + k * 128 + n * 2;
    bf16_t* U = (bf16_t*)(F.ws + WS_UA) + (size_t)g * UROWS * UAK + 512 + k * 128 + n * 2;
    float sr = 0.f, si = 0.f;
    constexpr int NST = NCHC + NCHL;
    auto rowof = [&](int st) -> int { if (st < NCHC) { const int cc = k ? (NCHC - 1 - st) : st; return NB * NCHL + b * NCHC + cc; } const int c = k ? (NCHL - 1 - (st - NCHC)) : (st - NCHC); return b * NCHL + c; };
#pragma unroll 1
    for (int st0 = 0; st0 < NST; st0 += 8) {
        f32x2 v[8]; int rws[8];
#pragma unroll
        for (int e = 0; e < 8; ++e) { rws[e] = rowof(st0 + e); v[e] = *(const f32x2*)(S + (size_t)rws[e] * 256); }
#pragma unroll
        for (int e = 0; e < 8; ++e) {
            *(unsigned*)(U + (size_t)rws[e] * UAK) = pk2(sr, si);
            const float t = ar * sr - ai * si + v[e].x; si = ar * si + ai * sr + v[e].y; sr = t;
        }
    }
}
__device__ __forceinline__ void ph_filter(Frame& F, int l, bool with_ctx) {
    LAS float* w4s = (LAS float*)F.lds;
    LAS float* red = w4s + 512;
    const float* w4 = F.in[29] + (size_t)l * 64 * 1024;
    const float MIND = -3.0701134573253944f, MAXD = -15.350567286626972f;
    const int nun = with_ctx ? 256 : 128;
    for (int unit = F.bid; unit < nun; unit += F.G) {
        const bool isc = unit >= 128; const int c0 = (unit & 127) * 4, Lh = isc ? CTXL : SEQ;
        const float* H3 = (const float*)(F.ws + (isc ? WS_H3C : WS_H3)); float* kT = (float*)(F.ws + (isc ? WS_KTC : WS_KT)); float* kinv = (float*)(F.ws + WS_KINV) + (isc ? 512 : 0);
        __syncthreads();
        { const int m = F.tid >> 3, e = F.tid & 7; w4s[F.tid] = w4[(size_t)m * 1024 + (e >> 2) * 512 + c0 + (e & 3)]; }
        LDS_WAIT(); __syncthreads();
        float dl[4]; float asum[4] = {0.f, 0.f, 0.f, 0.f};
#pragma unroll
        for (int ch = 0; ch < 4; ++ch) dl[ch] = fabsf(MIND + (float)(c0 + ch) * ((MAXD - MIND) / 511.0f));
        for (int t = F.tid; t < Lh; t += NTHREADS) {
            float acc[8] = {0.f, 0.f, 0.f, 0.f, 0.f, 0.f, 0.f, 0.f};
            const f32x4* hr = (const f32x4*)(H3 + (size_t)t * 64);
#pragma unroll 4
            for (int m4 = 0; m4 < 16; ++m4) { const f32x4 hv = hr[m4];
#pragma unroll
                for (int d = 0; d < 4; ++d)
#pragma unroll
                    for (int e = 0; e < 8; ++e) acc[e] += hv[d] * w4s[(m4 * 4 + d) * 8 + e]; }
            const float tt = (float)t / (float)(Lh - 1);
#pragma unroll
            for (int ch = 0; ch < 4; ++ch) {
                const float win = expf(-tt * dl[ch]) + 0.05f, vf = acc[ch] * win, vb = acc[4 + ch] * win;
                float* kr = kT + (size_t)(c0 + ch) * (2 * Lh);
                kr[t] = vf; asum[ch] += fabsf(vf);
                if (t >= 1) { kr[2 * Lh - t] = vb; asum[ch] += fabsf(vb); } else kr[Lh] = 0.f;
            }
        }
#pragma unroll
        for (int ch = 0; ch < 4; ++ch) { const float s = wave_sum(asum[ch]); if (F.lane == 0) red[F.wave * 8 + ch] = s; }
        LDS_WAIT(); __syncthreads();
        if (F.tid < 4) { float s = 0.f;
#pragma unroll
            for (int wv = 0; wv < 8; ++wv) s += red[wv * 8 + F.tid];
            kinv[c0 + F.tid] = 1.f / s; }
    }
    __syncthreads();
}
__device__ __forceinline__ void ph_fft(Frame& F, int l, bool with_ctx, size_t ut_off = WS_UT, size_t utc_off = WS_UTC) {
    LAS cf* KH = (LAS cf*)F.lds; LAS cf* XB = KH + 8192; LAS cf* tw = XB + 8192;
    const int tid = F.tid;
    for (int i = tid; i < 1024; i += NTHREADS) { float s, c; sincospif(-(float)i * (1.0f / 4096.0f), &s, &c); tw[i] = (cf){c, s}; }
    LDS_WAIT(); __syncthreads();
    const float* kTa = (const float*)(F.ws + WS_KT); const float* kinv = (const float*)(F.ws + WS_KINV); const float* hd = F.in[30] + l * 512;
    bf16_t* UT = (bf16_t*)(F.ws + ut_off);
    for (int c = F.bid; c < 512; c += F.G) {
        {
            const float sc = kinv[c]; const float* kr = kTa + (size_t)c * 8192 + tid * 16;
#pragma unroll
            for (int j = 0; j < 4; ++j) { const f32x4 v = *(const f32x4*)(kr + 4 * j);
#pragma unroll
                for (int e = 0; e < 4; ++e) KH[tid * 16 + 4 * j + e] = (cf){v[e] * sc, 0.f}; }
            LDS_WAIT(); __syncthreads();
            if (tid == 0) KH[0].x += hd[c];
            LDS_WAIT(); __syncthreads();
            fft8192(KH, tw, tid);
        }
#pragma unroll 1
        for (int pr = 0; pr < 2; ++pr) {
            bf16_t* u0 = UT + (size_t)c * ML + (size_t)(2 * pr) * SEQ + tid * 8; bf16_t* u1 = u0 + SEQ;
            { f32x4 a0, a1, b0, b1; unpack8(*(const u32x4*)u0, a0, a1); unpack8(*(const u32x4*)u1, b0, b1);
#pragma unroll
              for (int e = 0; e < 4; ++e) { XB[tid * 8 + e] = (cf){a0[e], b0[e]}; XB[tid * 8 + 4 + e] = (cf){a1[e], b1[e]}; }
#pragma unroll
              for (int e = 0; e < 8; ++e) XB[4096 + tid + NTHREADS * e] = (cf){0.f, 0.f}; }
            LDS_WAIT(); __syncthreads();
            fft8192(XB, tw, tid);
#pragma unroll
            for (int e = 0; e < 16; ++e) { const int i = tid + NTHREADS * e; const cf p = cmul(XB[i], KH[i]); XB[i] = (cf){p.x, -p.y}; }
            LDS_WAIT(); __syncthreads();
            fft8192(XB, tw, tid);
            { const float sn = 1.0f / 8192.0f; float zr[8], zi[8];
#pragma unroll
              for (int e = 0; e < 8; ++e) { const cf v = XB[tid * 8 + e]; zr[e] = v.x * sn; zi[e] = -v.y * sn; }
              bf16_t* d0 = u0; bf16_t* d1 = u1;
              u32x4 o; o.x = pk2(zr[0], zr[1]); o.y = pk2(zr[2], zr[3]); o.z = pk2(zr[4], zr[5]); o.w = pk2(zr[6], zr[7]); *(u32x4*)d0 = o;
              o.x = pk2(zi[0], zi[1]); o.y = pk2(zi[2], zi[3]); o.z = pk2(zi[4], zi[5]); o.w = pk2(zi[6], zi[7]); *(u32x4*)d1 = o; }
            LDS_WAIT(); __syncthreads();
        }
        if (with_ctx) {
            LAS float* kc = (LAS float*)XB; LAS float* uc = kc + 512;
            const float* kr = (const float*)(F.ws + WS_KTC) + (size_t)c * 512; const float sc = ((const float*)(F.ws + WS_KINV))[512 + c];
            bf16_t* ucg = (bf16_t*)(F.ws + utc_off) + (size_t)c * MC;
            kc[tid] = kr[tid] * sc + (tid == 0 ? hd[c] : 0.f);
            uc[tid] = bf1(ucg[tid]); uc[512 + tid] = bf1(ucg[512 + tid]);
            LDS_WAIT(); __syncthreads();
#pragma unroll 1
            for (int h = 0; h < 2; ++h) { const int o = tid + NTHREADS * h, b = o >> 8, t = o & 255; float s = 0.f;
#pragma unroll 8
                for (int s_ = 0; s_ < 256; ++s_) s += kc[(t - s_) & 511] * uc[b * 256 + s_];
                ucg[o] = (bf16_t)f2bf(s); }
            LDS_WAIT(); __syncthreads();
        }
    }
}
__device__ __forceinline__ void ph_post(Frame& F, int ntiles) {
    bf16_t* X0 = (bf16_t*)(F.ws + WS_X0); const bf16_t* UT = (const bf16_t*)(F.ws + WS_UT); const bf16_t* UTC = (const bf16_t*)(F.ws + WS_UTC);
    LAS bf16_t* zt = (LAS bf16_t*)F.lds;
    const int cg = F.tid & 7, rr = F.tid >> 3;
    for (int unit = F.bid; unit < ntiles * 8; unit += F.G) {
        const int pm = unit >> 3, cb = unit & 7, rt = pm * 256;
#pragma unroll
        for (int it = 0; it < 4; ++it) { const int id = it * NTHREADS + F.tid, ch = id >> 5, pc = id & 31;
            const bf16_t* src = pm < 64 ? UT + (size_t)(cb * 64 + ch) * ML + rt + pc * 8 : UTC + (size_t)(cb * 64 + ch) * MC + (rt - ML) + pc * 8;
            *(LAS u32x4*)(zt + ch * 264 + pc * 8) = *(const u32x4*)src; }
        LDS_WAIT(); __syncthreads();
#pragma unroll
        for (int k = 0; k < 4; ++k) { const int rl = rr * 4 + k; bf16_t* xp = X0 + (size_t)(rt + rl) * 512 + cb * 64 + cg * 8;
            f32x4 a, b; unpack8(*(const u32x4*)xp, a, b); float y[8];
#pragma unroll
            for (int e = 0; e < 8; ++e) y[e] = (e < 4 ? a[e] : b[e - 4]) * bf1(zt[(cg * 8 + e) * 264 + rl]);
            u32x4 o; o.x = pk2(y[0], y[1]); o.y = pk2(y[2], y[3]); o.z = pk2(y[4], y[5]); o.w = pk2(y[6], y[7]); *(u32x4*)xp = o; }
        LDS_WAIT(); __syncthreads();
    }
}
__device__ __forceinline__ void ph_final(Frame& F) {
    const float* g = F.in[35];
    for (int row = F.gw; row < ML; row += F.ngw) { float* xs = F.out + (size_t)row * D; f32x4 v[4]; float s = 0.f;
#pragma unroll
        for (int j = 0; j < 4; ++j) { v[j] = *(const f32x4*)(xs + 4 * F.lane + 256 * j); s += (v[j][0] * v[j][0] + v[j][1] * v[j][1]) + (v[j][2] * v[j][2] + v[j][3] * v[j][3]); }
        const float rs = rsqrtf(wave_sum(s) * (1.f / D) + EPS);
#pragma unroll
        for (int j = 0; j < 4; ++j) { const int d = 4 * F.lane + 256 * j; *(f32x4*)(xs + d) = (v[j] * rs) * *(const f32x4*)(g + d); } }
}
constexpr int NPH = 1 + 2 * 12 + 1;

__device__ __forceinline__ bool fresh(Frame& F) { asm volatile("" : "+v"(F.tid), "+v"(F.lane)); return true; }
template <int LAYER> __device__ __forceinline__ void layer_phases(Frame& F, const XcdBarrier& bar, int lo, int hi) {
    constexpr int l = LAYER, P0 = 1 + 12 * LAYER;
    constexpr bool last = (LAYER == 1);
    constexpr int nMa = last ? 64 : 68;
    unsigned char* ws = F.ws; const int c = F.bid, G = F.G;
    const float* modl = (const float*)(ws + WS_MOD) + (size_t)l * 5 * NMOD;
#define IN_PH(k) (lo <= P0 + (k) && P0 + (k) < hi && fresh(F))
#define SEAM(k) do { if (MK_PER_PHASE == 0 && (lo <= P0 + (k) && P0 + (k) < hi) && (P0 + (k) + 1) < hi) xcd_barrier(bar); } while (0)
#define LOCAL_SYNC() do { VM_WAIT(); __syncthreads(); } while (0)
#ifndef REP_MASK
#define REP_MASK 0
#endif
#define REPS(k) for (int rep_ = 0; rep_ < (((REP_MASK >> (k)) & 1) ? 2 : 1); ++rep_, (rep_ < (((REP_MASK >> (k)) & 1) ? 2 : 1) ? xcd_barrier(bar) : (void)0))
    if (IN_PH(0)) REPS(0) { ph_layer_prep<LAYER>(F); } SEAM(0);
    if (IN_PH(1)) REPS(1) {
        pg8::GridOrder S; S.init(1, nMa, 8, G, c, ws + WS_H, (size_t)256 * 1024 * 2, 0, ws + WS_WIN, (size_t)256 * 1024 * 2, 0);
        if (last) S.extra(4, 2, 64);
        EpiWinA E{(bf16_t*)(ws + WS_UA), (bf16_t*)(ws + WS_PBUF)};
        pg8::gemm_phase(F.lds, pg8::GemmP{1024, 1024, 1024}, S, E);
    } SEAM(1);
    if (IN_PH(2)) REPS(2) {
        pg8::GridOrder S; S.init(32, 3, 1, G, c, ws + WS_UA, (size_t)256 * UAK * 2, (size_t)UROWS * UAK * 2, ws + WS_WST, (size_t)256 * 512 * 2, (size_t)256 * 512 * 2);
        EpiSloc E{(float*)(ws + WS_SLOC)};
        pg8::gemm_phase(F.lds, pg8::GemmP{UAK, 512, 512}, S, E);
        ph_prep_sc(F, l, nMa * 256);
    } SEAM(2);
    if (IN_PH(3)) REPS(3) {
        pg8::GridOrder S; S.init(1, nMa, 6, G, c, ws + WS_H, (size_t)256 * 1024 * 2, 0, ws + WS_WIN + (size_t)2048 * 1024 * 2, (size_t)256 * 1024 * 2, 0);
        EpiBf16 E{(bf16_t*)(ws + WS_PBUF), 1536};
        pg8::gemm_phase(F.lds, pg8::GemmP{1024, 1024, 1024}, S, E);
        for (int g = G - 1 - c; g < 32; g += G) s5_chain(F, g);
    } SEAM(3);
    if (IN_PH(4)) REPS(4) { ph_prep_hy(F, l, nMa); LOCAL_SYNC(); ph_filter(F, l, !last); } SEAM(4);
    if (IN_PH(5)) REPS(5) {
        pg8::GridOrder S; S.init(32, 3, 2, G, c, ws + WS_UA, (size_t)256 * UAK * 2, (size_t)UROWS * UAK * 2, ws + WS_BTB, (size_t)256 * UAK * 2, (size_t)512 * UAK * 2);
        EpiYpre E{(bf16_t*)(ws + WS_YPRE)};
        pg8::gemm_phase(F.lds, pg8::GemmP{UAK, UAK, UAK}, S, E);
#ifdef FFT_TWICE
        ph_fft(F, l, !last, WS_GATE, WS_GATE + (size_t)17000000);
#endif
        ph_fft(F, l, !last);
    } SEAM(5);
    if (IN_PH(6)) REPS(6) { ph_post(F, nMa); } SEAM(6);
    if (IN_PH(7)) REPS(7) {
        pg8::GridOrder SG; SG.init(1, nMa, 4, G, c, ws + WS_H, (size_t)256 * 1024 * 2, 0, ws + WS_WIN + (size_t)3584 * 1024 * 2, (size_t)256 * 1024 * 2, 0);
        EpiGate EG{(bf16_t*)(ws + WS_GATE)};
        pg8::gemm_phase(F.lds, pg8::GemmP{1024, 1024, 1024}, SG, EG); LOCAL_SYNC();
        { pg8::GluOrder S; S.base.init(1, nMa, 4, G, c, ws + WS_YPRE, (size_t)256 * 512 * 2, 0, ws + WS_WGLU, 0, 0); S.B = (const char*)(ws + WS_WGLU); S.tB = (size_t)256 * 512 * 2;
          EpiBranch<0> E{(bf16_t*)(ws + WS_M), (const bf16_t*)(ws + WS_GATE)};
          pg8::gemm_phase(F.lds, pg8::GemmP{512, 512, 512}, S, E); LOCAL_SYNC(); }
        SG.B = (const char*)(ws + WS_WIN + (size_t)(3584 + 1024) * 1024 * 2);
        pg8::gemm_phase(F.lds, pg8::GemmP{1024, 1024, 1024}, SG, EG); LOCAL_SYNC();
        { pg8::GridOrder S; S.init(1, nMa, 4, G, c, ws + WS_SCA, (size_t)256 * 512 * 2, 0, ws + WS_WSC, (size_t)256 * 512 * 2, 0);
          EpiBranch<1> E{(bf16_t*)(ws + WS_M), (const bf16_t*)(ws + WS_GATE)};
          pg8::gemm_phase(F.lds, pg8::GemmP{512, 512, 512}, S, E); LOCAL_SYNC(); }
        SG.B = (const char*)(ws + WS_WIN + (size_t)(3584 + 2048) * 1024 * 2);
        pg8::gemm_phase(F.lds, pg8::GemmP{1024, 1024, 1024}, SG, EG); LOCAL_SYNC();
        { pg8::GridOrder S; S.init(1, nMa, 4, G, c, ws + WS_X0, (size_t)256 * 512 * 2, 0, ws + WS_WHY, (size_t)256 * 512 * 2, 0);
          EpiBranch<1> E{(bf16_t*)(ws + WS_M), (const bf16_t*)(ws + WS_GATE)};
          pg8::gemm_phase(F.lds, pg8::GemmP{512, 512, 512}, S, E); }
    } SEAM(7);
    if (IN_PH(8)) REPS(8) {
        pg8::GridOrder S; S.init(1, nMa, 4, G, c, ws + WS_M, (size_t)256 * 1024 * 2, 0, ws + WS_WOUT, (size_t)256 * 1024 * 2, 0);
        EpiResid E{F.out, (float*)(ws + WS_XC), modl + 2048};
        pg8::gemm_phase(F.lds, pg8::GemmP{1024, 1024, 1024}, S, E);
    } SEAM(8);
    if (IN_PH(9)) REPS(9) { norm_rows<false>(F, nMa * 256, F.gw, F.ngw, F.in[7] + l * D, modl, 3072, (bf16_t*)(ws + WS_H)); } SEAM(9);
    if (IN_PH(10)) REPS(10) {
        pg8::GridOrder S; S.init(1, nMa, 16, G, c, ws + WS_H, (size_t)256 * 1024 * 2, 0, ws + WS_W1, (size_t)256 * 1024 * 2, 0);
        EpiRelu2 E{(bf16_t*)(ws + WS_R)};
        pg8::gemm_phase(F.lds, pg8::GemmP{1024, 1024, 1024}, S, E);
    } SEAM(10);
    if (IN_PH(11)) REPS(11) {
        pg8::GridOrder S; S.init(1, nMa, 4, G, c, ws + WS_R, (size_t)256 * 4096 * 2, 0, ws + WS_W2, (size_t)256 * 4096 * 2, 0);
        EpiResid E{F.out, (float*)(ws + WS_XC), modl + 5120};
        pg8::gemm_phase(F.lds, pg8::GemmP{4096, 4096, 4096}, S, E);
    } SEAM(11);
#undef IN_PH
#undef SEAM
}

__global__ void __launch_bounds__(NTHREADS, 2) mk_fwd(Args args) {
    extern __shared__ __attribute__((aligned(16))) unsigned char lds_raw[];
    Frame F;
    F.lds = (LAS unsigned char*)lds_raw;
    F.tid = threadIdx.x; F.lane = F.tid & 63; F.wave = __builtin_amdgcn_readfirstlane(F.tid >> 6);
    F.G = gridDim.x; F.bid = blockIdx.x; F.gw = F.bid * NWAVES + F.wave; F.ngw = F.G * NWAVES;
    F.in = (const float* const __attribute__((address_space(4)))*)__builtin_amdgcn_kernarg_segment_ptr();
    F.out = args.out; F.ws = args.ws;
    volatile LAS unsigned* MISC = (volatile LAS unsigned*)(F.lds + MISC_OFF);
    for (int u = F.tid; u < (LDS_BYTES - LDSCTL_OFF) / 4; u += NTHREADS) ((LAS unsigned*)(F.lds + LDSCTL_OFF))[u] = 0u;
    __syncthreads();
    XcdBarrier bar; bar.bar = (unsigned*)(F.ws + WS_CTL) + CW_BAR; bar.x = 0; bar.st = nullptr;
    if (MK_PER_PHASE == 0) bar = xcd_barrier_post((unsigned*)(F.ws + WS_CTL) + CW_BAR, MISC + 8);
#ifdef DBG_LO
    const int lo = DBG_LO, hi = DBG_HI;
#else
    const int lo = args.ph_lo, hi = args.ph_hi;
#endif
    if (lo <= 0 && 0 < hi) { ph_pre(F); if (MK_PER_PHASE == 0 && 1 < hi) xcd_barrier(bar); }
    layer_phases<0>(F, bar, lo, hi);
    layer_phases<1>(F, bar, lo, hi);
    if (lo <= NPH - 1 && NPH - 1 < hi) ph_final(F);
}
}

extern "C" void kernel_launch(void* const* d_in, const int* in_sizes, int n_in, void* d_out, int out_size, void* d_ws, size_t ws_size, hipStream_t stream) {
    using namespace mk;
    static int grid = 0;
    if (grid == 0) {
        if (n_in != 36 || out_size != ML * D || ws_size < WS_END) { fprintf(stderr, "kernel_launch: unexpected shapes (n_in %d out %d ws %zu need %zu)\n", n_in, out_size, ws_size, (size_t)WS_END); grid = -1; return; }
        int dev = 0, cus = 0, per_cu = 0;
        if (hipGetDevice(&dev) != hipSuccess || hipDeviceGetAttribute(&cus, hipDeviceAttributeMultiprocessorCount, dev) != hipSuccess) { grid = -1; return; }
        if (hipFuncSetAttribute((const void*)mk_fwd, hipFuncAttributeMaxDynamicSharedMemorySize, LDS_BYTES) != hipSuccess) { fprintf(stderr, "kernel_launch: hipFuncSetAttribute failed\n"); grid = -1; return; }
        if (hipOccupancyMaxActiveBlocksPerMultiprocessor(&per_cu, (const void*)mk_fwd, NTHREADS, LDS_BYTES) != hipSuccess || per_cu < 1) { fprintf(stderr, "kernel_launch: occupancy query says %d\n", per_cu); (void)hipGetLastError(); grid = -1; return; }
        grid = cus;
    }
    if (grid < 0) return;
    (void)hipMemsetAsync((char*)d_ws + WS_CTL, 0, CTL_BYTES, stream);
    Args a{};
    for (int i = 0; i < 36; ++i) a.in[i] = (const float*)d_in[i];
    a.out = (float*)d_out; a.ws = (unsigned char*)d_ws;
#if MK_PER_PHASE
    for (int ph = 0; ph < NPH; ++ph) { a.ph_lo = ph; a.ph_hi = ph + 1; hipLaunchKernelGGL(mk_fwd, dim3(grid), dim3(NTHREADS), LDS_BYTES, stream, a); }
#else
    a.ph_lo = 0; a.ph_hi = NPH;
    hipLaunchKernelGGL(mk_fwd, dim3(grid), dim3(NTHREADS), LDS_BYTES, stream, a);
#endif
}
```
